# Optimizing an MI355X kernel written in HIP

```python
import math
import jax, jax.numpy as jnp
from jax import lax
import numpy as np

D_MODEL = 1024
BATCH = 8
SEQ = 4096
DEPTH = 2
DEC_BATCH = 16
DEC_SEQ = 4096
PAST_LEN = 128

ATT_HEADS = 8
ATT_KV_HEADS = 2
ATT_GROUP = ATT_HEADS // ATT_KV_HEADS
ATT_HEAD_DIM = 64
WINDOW = 128
ATT_BLOCK = 128
ROPE_THETA = 500000.0
ROPE_DIM = ATT_HEAD_DIM // 4
HG_HEADS = 8
HG_KEY_DIM = 64
HG_VAL_DIM = 64
HG_CHUNK = 64
D_FF = 4 * D_MODEL
ALPHA = (2 * DEPTH) ** 0.25
BETA = (8 * DEPTH) ** -0.25
LN_EPS = 1e-5
RMS_EPS = 1e-6

ATT_Q = ATT_HEADS * ATT_HEAD_DIM
ATT_KV = ATT_KV_HEADS * ATT_HEAD_DIM
HG_K = HG_HEADS * HG_KEY_DIM
HG_V = HG_HEADS * HG_VAL_DIM
SPLIT_SIZES = (ATT_Q, ATT_KV, ATT_KV, HG_K, HG_K, HG_K, HG_V, HG_V, D_MODEL, D_MODEL)
D_IN = sum(SPLIT_SIZES)

kernel_name = 'hybrid_gated_swa_hgrn2_encoder'


def layer_norm(x, g, b):
    xf = x.astype(jnp.float32)
    mu = jnp.mean(xf, axis=-1, keepdims=True)
    var = jnp.mean(jnp.square(xf - mu), axis=-1, keepdims=True)
    y = (xf - mu) * lax.rsqrt(var + LN_EPS) * g.astype(jnp.float32) + b.astype(jnp.float32)
    return y.astype(x.dtype)


def partial_rope(x, positions):
    inv = ROPE_THETA ** (-jnp.arange(0, ROPE_DIM, 2, dtype=jnp.float32) / ROPE_DIM)
    ang = positions.astype(jnp.float32)[:, None] * inv[None, :]
    cos = jnp.cos(ang)[None, :, None, :]
    sin = jnp.sin(ang)[None, :, None, :]
    xr = x[..., :ROPE_DIM].astype(jnp.float32)
    x1, x2 = xr[..., :ROPE_DIM // 2], xr[..., ROPE_DIM // 2:]
    rot = jnp.concatenate([x1 * cos - x2 * sin, x2 * cos + x1 * sin], axis=-1).astype(x.dtype)
    return jnp.concatenate([rot, x[..., ROPE_DIM:]], axis=-1)


def window_attention(q, k, v, sink):
    B, S = q.shape[0], q.shape[1]
    nb = S // ATT_BLOCK
    qb = q.reshape(B, nb, ATT_BLOCK, ATT_KV_HEADS, ATT_GROUP, ATT_HEAD_DIM)
    pad = ((0, 0), (ATT_BLOCK, ATT_BLOCK), (0, 0), (0, 0))
    kp = jnp.pad(k, pad).reshape(B, nb + 2, ATT_BLOCK, ATT_KV_HEADS, ATT_HEAD_DIM)
    vp = jnp.pad(v, pad).reshape(B, nb + 2, ATT_BLOCK, ATT_KV_HEADS, ATT_HEAD_DIM)
    kw = jnp.concatenate([kp[:, :-2], kp[:, 1:-1], kp[:, 2:]], axis=2)
    vw = jnp.concatenate([vp[:, :-2], vp[:, 1:-1], vp[:, 2:]], axis=2)
    qi = jnp.arange(ATT_BLOCK)[:, None]
    kj = jnp.arange(3 * ATT_BLOCK)[None, :]
    blk = jnp.arange(nb)[:, None, None]
    kpos = blk * ATT_BLOCK + kj - ATT_BLOCK
    mask = (jnp.abs(kj - ATT_BLOCK - qi) <= WINDOW) & (kpos >= 0) & (kpos < S)
    scale = ATT_HEAD_DIM ** -0.5
    s = jnp.einsum('bnqkgd,bnjkd->bnkgqj', qb, kw).astype(jnp.float32) * scale
    s = jnp.where(mask[None, :, None, None, :, :], s, -jnp.inf)
    sk = sink.astype(jnp.float32).reshape(ATT_KV_HEADS, ATT_GROUP)[None, None, :, :, None, None]
    m = jnp.maximum(jnp.max(s, axis=-1, keepdims=True), sk)
    p = jnp.exp(s - m)
    denom = jnp.sum(p, axis=-1, keepdims=True) + jnp.exp(sk - m)
    p = (p / denom).astype(v.dtype)
    o = jnp.einsum('bnkgqj,bnjkd->bnqkgd', p, vw)
    return o.reshape(B, S, ATT_Q)


def gla_chunk_scan(q, k, v, logf):
    B, L, H, dk = q.shape
    dv = v.shape[-1]
    nc = L // HG_CHUNK

    def to_chunks(a):
        return a.reshape(B, nc, HG_CHUNK, H, a.shape[-1]).transpose(1, 0, 3, 2, 4)

    tri = jnp.arange(HG_CHUNK)[:, None] >= jnp.arange(HG_CHUNK)[None, :]

    def step(S, inp):
        qc, kc, vc, gc = inp
        b = jnp.cumsum(gc, axis=2)
        diff = b[:, :, :, None, :] - b[:, :, None, :, :]
        dec = jnp.exp(jnp.where(tri[:, :, None], diff, -jnp.inf))
        A = jnp.einsum('bhtd,bhsd,bhtsd->bhts', qc, kc, dec)
        o = jnp.einsum('bhts,bhse->bhte', A, vc) + jnp.einsum('bhtd,bhde->bhte', qc * jnp.exp(b), S)
        b_last = b[:, :, -1:, :]
        S = jnp.exp(b_last[:, :, 0, :])[..., None] * S + jnp.einsum('bhsd,bhse->bhde', kc * jnp.exp(b_last - b), vc)
        return S, o

    S0 = jnp.zeros((B, H, dk, dv), jnp.float32)
    _, o = lax.scan(step, S0, (to_chunks(q), to_chunks(k), to_chunks(v), to_chunks(logf)))
    return o.transpose(1, 0, 3, 2, 4).reshape(B, L, H, dv)


def hgrn2_branch(hq, hf_fwd, hf_bwd, hi, hg, lower, norm_g):
    B, L = hq.shape[0], hq.shape[1]
    q = jax.nn.silu(hq.astype(jnp.float32)).reshape(B, L, HG_HEADS, HG_KEY_DIM) * HG_KEY_DIM ** -0.5
    v = hi.astype(jnp.float32).reshape(B, L, HG_HEADS, HG_VAL_DIM)

    def gates(f_pre, lb):
        f = lb + (1.0 - lb) * jax.nn.sigmoid(f_pre.astype(jnp.float32))
        f = f.reshape(B, L, HG_HEADS, HG_KEY_DIM)
        return 1.0 - f, jnp.log(f)

    k_f, g_f = gates(hf_fwd, lower[0])
    k_b, g_b = gates(hf_bwd, lower[1])
    o_f = gla_chunk_scan(q, k_f, v, g_f)
    rev = lambda a: jnp.flip(a, axis=1)
    o_b = rev(gla_chunk_scan(rev(q), rev(k_b), rev(v), rev(g_b)))
    o = o_f + o_b
    o = o * lax.rsqrt(jnp.mean(jnp.square(o), axis=-1, keepdims=True) + RMS_EPS) * norm_g.astype(jnp.float32)
    o = o.reshape(B, L, HG_V) * jax.nn.silu(hg.astype(jnp.float32))
    return o.astype(hq.dtype)


def trunk(x, w_in, att_sink, hgrn_lb, hgrn_norm_g, w_proj_att, w_proj_hgrn, w_out,
          ln1_g, ln1_b, w_ff1, w_ff2, ln2_g, ln2_b):
    B, L, _ = x.shape
    positions = jnp.arange(L)
    sm = jax.nn.softmax(hgrn_lb.astype(jnp.float32), axis=0)
    lower = jnp.cumsum(sm, axis=0) - sm[0:1]
    cuts = [int(c) for c in np.cumsum(SPLIT_SIZES)[:-1]]
    for l in range(DEPTH):
        h = x @ w_in[l]
        aq, ak, av, hq, hf_f, hf_b, hi, hg, ga, gb = jnp.split(h, cuts, axis=-1)
        q = partial_rope(aq.reshape(B, L, ATT_HEADS, ATT_HEAD_DIM), positions)
        k = partial_rope(ak.reshape(B, L, ATT_KV_HEADS, ATT_HEAD_DIM), positions)
        v = av.reshape(B, L, ATT_KV_HEADS, ATT_HEAD_DIM)
        o_att = window_attention(q, k, v, att_sink[l])
        o_hg = hgrn2_branch(hq, hf_f, hf_b, hi, hg, lower[l], hgrn_norm_g[l])
        mixed = jax.nn.sigmoid(ga) * (o_att @ w_proj_att[l]) + jax.nn.sigmoid(gb) * (o_hg @ w_proj_hgrn[l])
        x = layer_norm(ALPHA * x + mixed @ w_out[l], ln1_g[l], ln1_b[l])
        ff = jnp.square(jax.nn.relu(x @ w_ff1[l])) @ w_ff2[l]
        x = layer_norm(ALPHA * x + ff, ln2_g[l], ln2_b[l])
    return x


def setup_inputs(seed: int = 0) -> dict:
    key = jax.random.key(seed)
    ks = jax.random.split(key, 16)
    n = jax.random.normal
    f32 = jnp.float32
    return {
        'x_prompt': n(ks[0], (BATCH, SEQ, D_MODEL), f32),
        'x_sample': n(ks[1], (DEC_BATCH, DEC_SEQ, D_MODEL), f32),
        'w_in': n(ks[2], (DEPTH, D_MODEL, D_IN), f32) * D_MODEL ** -0.5,
        'att_sink': n(ks[3], (DEPTH, ATT_HEADS), f32) * 0.5,
        'hgrn_lb': n(ks[4], (DEPTH, 2, HG_K), f32) * 0.5,
        'hgrn_norm_g': 1.0 + 0.02 * n(ks[5], (DEPTH, HG_VAL_DIM), f32),
        'w_proj_att': n(ks[6], (DEPTH, ATT_Q, D_MODEL), f32) * ATT_Q ** -0.5,
        'w_proj_hgrn': n(ks[7], (DEPTH, HG_V, D_MODEL), f32) * HG_V ** -0.5,
        'w_out': n(ks[8], (DEPTH, D_MODEL, D_MODEL), f32) * (D_MODEL ** -0.5 * BETA),
        'ln1_g': 1.0 + 0.02 * n(ks[9], (DEPTH, D_MODEL), f32),
        'ln1_b': 0.02 * n(ks[10], (DEPTH, D_MODEL), f32),
        'w_ff1': n(ks[11], (DEPTH, D_MODEL, D_FF), f32) * D_MODEL ** -0.5,
        'w_ff2': n(ks[12], (DEPTH, D_FF, D_MODEL), f32) * (D_FF ** -0.5 * BETA),
        'ln2_g': 1.0 + 0.02 * n(ks[13], (DEPTH, D_MODEL), f32),
        'ln2_b': 0.02 * n(ks[14], (DEPTH, D_MODEL), f32),
    }


def reference(x_prompt, x_sample, w_in, att_sink, hgrn_lb, hgrn_norm_g, w_proj_att, w_proj_hgrn,
              w_out, ln1_g, ln1_b, w_ff1, w_ff2, ln2_g, ln2_b):
    y_prompt = trunk(x_prompt, w_in, att_sink, hgrn_lb, hgrn_norm_g, w_proj_att, w_proj_hgrn, w_out,
                     ln1_g, ln1_b, w_ff1, w_ff2, ln2_g, ln2_b)
    y_sample = trunk(x_sample, w_in, att_sink, hgrn_lb, hgrn_norm_g, w_proj_att, w_proj_hgrn, w_out,
                     ln1_g, ln1_b, w_ff1, w_ff2, ln2_g, ln2_b)
    return (y_prompt, y_sample)
```

```cpp
#include <hip/hip_runtime.h>
#include <hip/hip_cooperative_groups.h>
#include <cstdio>
#include <cstdint>
namespace cg = cooperative_groups;
namespace pg8 {
#define PG8_LAS __attribute__((address_space(3)))
typedef unsigned short bf16_t;
typedef short bf16x8 __attribute__((ext_vector_type(8)));
typedef float f32x4 __attribute__((ext_vector_type(4)));
typedef unsigned u32x4 __attribute__((ext_vector_type(4)));
constexpr int BM = 256, BK = 64, HALF = 128, HTB = HALF * BK * 2  , STAGE_BYTES = 8 * HTB, NXCD = 8, WGM = 8;

__host__ __device__ __forceinline__ int lds_byte(int r, int c) { const int st = (r >> 4) * 2 + (c >> 5), rr = r & 15, cc = c & 31, ob = rr * 64 + cc * 2; return st * 1024 + (ob ^ (((ob >> 9) & 1) << 5)); }
__host__ __device__ __forceinline__ void stage_rc(int b, int& R, int& C) { const int st = b / 1024, sb = b % 1024, swz = sb ^ (((sb >> 9) & 1) << 5); R = (st >> 1) * 16 + swz / 64; C = (st & 1) * 32 + (swz % 64) / 2; }
__host__ __device__ __forceinline__ int perm32(int rho) { const int n = rho >> 4, i = rho & 15; return 8 * (i >> 2) + 4 * n + (i & 3); }

struct Unit { int pm, pn; };
struct Gemm { const bf16_t* A; const bf16_t* Bt; int M, N, K; };

struct StaticOrder {
    int nM, nN, nwg, G, c;
    __host__ __device__ void init(int M, int N, int G_, int c_) { nM = M / BM; nN = N / BM; nwg = nM * nN; G = G_; c = c_; }
    __host__ __device__ bool next(int i, Unit& u) const {
        const long L = (long)i * G + c; if (L >= nwg) return false;
        int wgid = (int)L; { const int q = nwg / NXCD, r = nwg % NXCD, xcd = wgid % NXCD, off = wgid / NXCD; wgid = (xcd < r ? xcd * (q + 1) : r * (q + 1) + (xcd - r) * q) + off; }
        const int nig = WGM * nN, gid = wgid / nig, fm = gid * WGM, gsz = (nM - fm) < WGM ? (nM - fm) : WGM;
        u.pm = fm + ((wgid % nig) % gsz); u.pn = (wgid % nig) / gsz; return true;
    }
    __device__ __forceinline__ void a_ready(const Unit&) const {}
    __device__ __forceinline__ void done(const Unit&) const {}
};

__device__ __forceinline__ unsigned cvt_pk_bf16(float lo, float hi) { unsigned r; asm volatile("v_cvt_pk_bf16_f32 %0, %1, %2" : "=v"(r) : "v"(lo), "v"(hi)); return r; }
typedef float f32x2 __attribute__((ext_vector_type(2)));
template <class Epi, class Sched, bool ALIGN_EPI = false, bool SP2 = false>
__device__ __forceinline__ void gemm_phase(PG8_LAS unsigned char* lds, const Gemm g, const Sched& S, const Epi& E) {
    int tid_ = threadIdx.x; asm volatile("" : "+v"(tid_));
    const int tid = tid_, wid = __builtin_amdgcn_readfirstlane(tid >> 6), lane = tid & 63, wr = wid >> 2, wc = wid & 3, fr = lane & 15, fq = lane >> 4;
    const int K = g.K, nt = K / BK;
    unsigned voffA[2], voffB[2];
#pragma unroll
    for (int i = 0; i < 2; ++i) { int R, C; stage_rc(tid * 16 + i * 8192, R, C); const int Rb = Epi::PERM ? ((R & ~31) + perm32(R & 31)) : R;
        voffA[i] = (unsigned)(R * K + C) * 2u; voffB[i] = (unsigned)(Rb * K + C) * 2u; }
    const size_t kstep = (size_t)(BK * 2);
    const size_t hstep = (size_t)HALF * K * 2;
    const size_t tstep = 2 * hstep;
    const unsigned ldsw = (unsigned)wid * 1024u;
    const int aoff = lds_byte(wr * 64 + fr, fq * 8), boff = lds_byte(wc * 32 + fr, fq * 8);
#define PG8_SA(b, h) (((b) * 2 + (h)) * HTB)
#define PG8_SB(b, h) ((4 + (b) * 2 + (h)) * HTB)
#define PG8_STAGE(bufoff, gbase, voff) do { _Pragma("unroll") for (int _i = 0; _i < 2; ++_i) \
        __builtin_amdgcn_global_load_lds((const unsigned*)((const char*)(gbase) + (voff)[_i]), (PG8_LAS unsigned*)(lds + (bufoff) + ldsw + _i * 8192), 16, 0, 0); } while (0)
#define PG8_LDA(dst, b, h) do { _Pragma("unroll") for (int m = 0; m < 4; ++m) _Pragma("unroll") for (int k = 0; k < 2; ++k) dst[m][k] = *(const PG8_LAS bf16x8*)(lds + PG8_SA(b, h) + aoff + m * 2048 + k * 1024); } while (0)
#define PG8_LDB(dst, b, h) do { _Pragma("unroll") for (int n = 0; n < 2; ++n) _Pragma("unroll") for (int k = 0; k < 2; ++k) dst[n][k] = *(const PG8_LAS bf16x8*)(lds + PG8_SB(b, h) + boff + n * 2048 + k * 1024); } while (0)
#define PG8_MMA(ai, bj, At, Bt) do { __builtin_amdgcn_s_setprio(1); _Pragma("unroll") for (int m = 0; m < 4; ++m) _Pragma("unroll") for (int n = 0; n < 2; ++n) _Pragma("unroll") for (int k = 0; k < 2; ++k) \
        acc[ai][bj][m][n] = __builtin_amdgcn_mfma_f32_16x16x32_bf16(Bt[n][k], At[m][k], acc[ai][bj][m][n], 0, 0, 0); __builtin_amdgcn_s_setprio(0); } while (0)
#define PG8_WAIT_V(n) asm volatile("s_waitcnt vmcnt(" #n ")" ::: "memory")
#define PG8_WAIT_L(n) asm volatile("s_waitcnt lgkmcnt(" #n ")" ::: "memory")
#define PG8_BAR __builtin_amdgcn_s_barrier()
#define PG8_SCHED __builtin_amdgcn_sched_barrier(0)
    Unit cur, nxt; int ui = 0;
    if (!S.next(0, cur)) return;
    f32x4 acc[2][2][4][2];
#pragma unroll
    for (int a = 0; a < 2; ++a)
#pragma unroll
        for (int b = 0; b < 2; ++b)
#pragma unroll
            for (int m = 0; m < 4; ++m)
#pragma unroll
                for (int n = 0; n < 2; ++n) acc[a][b][m][n] = (f32x4){0.f, 0.f, 0.f, 0.f};
    bf16x8 At[4][2], B0[2][2], B1[2][2];
    const char* cA = (const char*)g.A + (size_t)cur.pm * tstep; const char* cB = (const char*)g.Bt + (size_t)cur.pn * tstep;
    S.a_ready(cur);
    if constexpr (SP2) {
        PG8_STAGE(PG8_SB(0, 0), cB, voffB); PG8_STAGE(PG8_SB(0, 1), cB + hstep, voffB); PG8_STAGE(PG8_SA(0, 0), cA, voffA); PG8_STAGE(PG8_SA(0, 1), cA + hstep, voffA);
        if (wr == 1) PG8_BAR;
        PG8_WAIT_V(2); PG8_BAR;
        PG8_STAGE(PG8_SB(1, 0), cB + kstep, voffB); PG8_STAGE(PG8_SA(1, 0), cA + kstep, voffA); PG8_STAGE(PG8_SB(1, 1), cB + hstep + kstep, voffB);
        PG8_WAIT_V(6); PG8_BAR;
    } else {
        PG8_STAGE(PG8_SB(0, 0), cB, voffB); PG8_STAGE(PG8_SA(0, 0), cA, voffA); PG8_STAGE(PG8_SB(0, 1), cB + hstep, voffB); PG8_STAGE(PG8_SA(0, 1), cA + hstep, voffA);
        if (wr == 1) PG8_BAR;
        PG8_WAIT_V(4); PG8_BAR;
        PG8_STAGE(PG8_SB(1, 0), cB + kstep, voffB); PG8_STAGE(PG8_SA(1, 0), cA + kstep, voffA); PG8_STAGE(PG8_SB(1, 1), cB + hstep + kstep, voffB);
        PG8_WAIT_V(6); PG8_BAR;
    }
    for (;;) {
        const bool has_next = S.next(ui + 1, nxt);
        const char* nA = has_next ? (const char*)g.A + (size_t)nxt.pm * tstep : cA; const char* nB = has_next ? (const char*)g.Bt + (size_t)nxt.pn * tstep : cB;
        for (int t = 0; t < nt; t += 2) {
            const bool last = (t == nt - 2);
            const char* a1 = cA + (size_t)(t + 1) * kstep;
            const char* a2 = last ? nA : cA + (size_t)(t + 2) * kstep; const char* b2 = last ? nB : cB + (size_t)(t + 2) * kstep;
            const char* a3 = a2 + kstep; const char* b3 = b2 + kstep;
            if (last && has_next) S.a_ready(nxt);
            if constexpr (SP2) {
            PG8_LDB(B0, 0, 0); PG8_LDB(B1, 0, 1); PG8_SCHED; PG8_LDA(At, 0, 0); PG8_STAGE(PG8_SA(1, 1), a1 + hstep, voffA);
            PG8_WAIT_V(8); PG8_WAIT_L(0); PG8_BAR; PG8_MMA(0, 0, At, B0); PG8_MMA(0, 1, At, B1); PG8_BAR; PG8_SCHED;
            PG8_LDA(At, 0, 1); PG8_STAGE(PG8_SB(0, 0), b2, voffB); PG8_STAGE(PG8_SB(0, 1), b2 + hstep, voffB); PG8_STAGE(PG8_SA(0, 0), a2, voffA);
            PG8_WAIT_V(8); PG8_WAIT_L(0); PG8_BAR; PG8_MMA(1, 0, At, B0); PG8_MMA(1, 1, At, B1); PG8_BAR; PG8_SCHED;
            PG8_LDB(B0, 1, 0); PG8_LDB(B1, 1, 1); PG8_SCHED; PG8_LDA(At, 1, 0); PG8_STAGE(PG8_SA(0, 1), a2 + hstep, voffA);
            PG8_WAIT_V(8); PG8_WAIT_L(0); PG8_BAR; PG8_MMA(0, 0, At, B0); PG8_MMA(0, 1, At, B1); PG8_BAR; PG8_SCHED;
            PG8_LDA(At, 1, 1); PG8_STAGE(PG8_SB(1, 0), b3, voffB); PG8_STAGE(PG8_SB(1, 1), b3 + hstep, voffB); PG8_STAGE(PG8_SA(1, 0), a3, voffA);
            PG8_WAIT_V(8); PG8_WAIT_L(0); PG8_BAR; PG8_MMA(1, 0, At, B0); PG8_MMA(1, 1, At, B1); PG8_BAR; PG8_SCHED;
            } else {
            PG8_LDB(B0, 0, 0); PG8_SCHED; PG8_LDA(At, 0, 0); PG8_STAGE(PG8_SA(1, 1), a1 + hstep, voffA);
            PG8_WAIT_L(8); PG8_BAR; PG8_WAIT_L(0); PG8_MMA(0, 0, At, B0); PG8_BAR; PG8_SCHED;
            PG8_LDB(B1, 0, 1); PG8_STAGE(PG8_SB(0, 0), b2, voffB);
            PG8_BAR; PG8_WAIT_L(0); PG8_MMA(0, 1, At, B1); PG8_BAR;
            PG8_LDA(At, 0, 1); PG8_STAGE(PG8_SA(0, 0), a2, voffA);
            PG8_BAR; PG8_WAIT_L(0); PG8_MMA(1, 0, At, B0); PG8_BAR; PG8_SCHED;
            PG8_STAGE(PG8_SB(0, 1), b2 + hstep, voffB);
            PG8_WAIT_V(6); PG8_BAR; PG8_MMA(1, 1, At, B1); PG8_BAR;
            PG8_LDB(B0, 1, 0); PG8_SCHED; PG8_LDA(At, 1, 0); PG8_STAGE(PG8_SA(0, 1), a2 + hstep, voffA);
            PG8_WAIT_L(8); PG8_BAR; PG8_WAIT_L(0); PG8_MMA(0, 0, At, B0); PG8_BAR; PG8_SCHED;
            PG8_LDB(B1, 1, 1); PG8_STAGE(PG8_SB(1, 0), b3, voffB);
            PG8_BAR; PG8_WAIT_L(0); PG8_MMA(0, 1, At, B1); PG8_BAR;
            PG8_LDA(At, 1, 1); PG8_STAGE(PG8_SA(1, 0), a3, voffA);
            PG8_BAR; PG8_WAIT_L(0); PG8_MMA(1, 0, At, B0); PG8_BAR; PG8_SCHED;
            PG8_STAGE(PG8_SB(1, 1), b3 + hstep, voffB);
            PG8_WAIT_V(6); PG8_BAR; PG8_MMA(1, 1, At, B1); PG8_BAR;
            }
        }
        if constexpr (ALIGN_EPI) { if (wr == 0) PG8_BAR; }
        if constexpr (!Epi::AFTER_DRAIN) { E(acc, cur, wr, wc, fr, fq); S.done(cur); }
        if (!has_next) break;
#pragma unroll
        for (int a = 0; a < 2; ++a)
#pragma unroll
            for (int b = 0; b < 2; ++b)
#pragma unroll
                for (int m = 0; m < 4; ++m)
#pragma unroll
                    for (int n = 0; n < 2; ++n) acc[a][b][m][n] = (f32x4){0.f, 0.f, 0.f, 0.f};
        cur = nxt; cA = nA; cB = nB; ++ui;
        if constexpr (ALIGN_EPI) { if (wr == 1) PG8_BAR; }
    }
    PG8_WAIT_V(0);
    if constexpr (!ALIGN_EPI) { if (wr == 0) PG8_BAR; }
    PG8_BAR;
    if constexpr (Epi::AFTER_DRAIN) { E.fused(acc, cur, wr, wc, fr, fq, lds, wid, lane); S.done(cur); }
#undef PG8_SA
#undef PG8_SB
#undef PG8_STAGE
#undef PG8_LDA
#undef PG8_LDB
#undef PG8_MMA
#undef PG8_WAIT_V
#undef PG8_WAIT_L
#undef PG8_BAR
#undef PG8_SCHED
}
}

constexpr int NTHR = 512;
constexpr int DM = 1024, SEQ = 4096, HP = 5376, DFF = 4096;
constexpr int GSEQ = 12, MG = GSEQ * SEQ, NGROUPS = 2;
constexpr int XSPLIT = 8 * SEQ;
constexpr int C_AK = 512, C_AV = 640, C_HQ = 768, C_HFF = 1280, C_HI = 2304, C_HG = 2816, C_GA = 3328, C_GB = 4352;
constexpr float ALPHA = 1.4142135623730951f, LN_EPS = 1e-5f, RMS_EPS = 1e-6f;
constexpr int LDS_BYTES = 147456;

#define LAS __attribute__((address_space(3)))
typedef unsigned short bf16;
typedef unsigned u32x4 __attribute__((ext_vector_type(4)));
typedef unsigned u32x2 __attribute__((ext_vector_type(2)));
typedef float f32x4 __attribute__((ext_vector_type(4)));
typedef short bf16x8 __attribute__((ext_vector_type(8)));

constexpr size_t MiB = 1u << 20;
constexpr size_t WS_LBV = 32768;
constexpr size_t WS_CS1 = 65536, WS_BW1 = 98304, WS_CSIN = 131072, WS_BWIN = 163840;
constexpr size_t WS_ROPE = 1 * MiB;
constexpr size_t WS_W = 2 * MiB, WS_WL = 31 * MiB;
constexpr size_t WO_PA = 10 * MiB + MiB / 2, WO_PH = 11 * MiB + MiB / 2, WO_OUT = 12 * MiB + MiB / 2, WO_FF1 = 14 * MiB + MiB / 2, WO_FF2 = 22 * MiB + MiB / 2;
constexpr size_t WS_XB = 64 * MiB, WS_H = 160 * MiB, WS_OATT = 664 * MiB, WS_OHG = 712 * MiB, WS_MIX = 760 * MiB, WS_SB = 856 * MiB, WS_DEC = 952 * MiB;
constexpr size_t WS_ST1 = 955 * MiB, WS_ST2 = WS_ST1 + 512 * 1024, WS_END = 958 * MiB;
static_assert((size_t)MG * HP * 2 <= WS_OATT - WS_H && (size_t)MG * DM * 2 <= WS_H - WS_XB && (size_t)MG * 512 * 2 <= WS_OHG - WS_OATT && (size_t)MG * DM * 2 <= WS_SB - WS_MIX && (size_t)GSEQ * 16 * 64 * 8192 <= WS_DEC - WS_SB && (size_t)GSEQ * 16 * 64 * 256 <= WS_ST1 - WS_DEC && (size_t)MG * 8 <= 512 * 1024, "d_ws map");

__device__ __forceinline__ float bf2f(unsigned short u) { return __uint_as_float((unsigned)u << 16); }
__device__ __forceinline__ float bflo(unsigned w) { return __uint_as_float(w << 16); }
__device__ __forceinline__ float bfhi(unsigned w) { return __uint_as_float(w & 0xffff0000u); }
__device__ __forceinline__ unsigned f2bf(float f) { unsigned u = __builtin_bit_cast(unsigned, f); return (u + 0x7fffu + ((u >> 16) & 1u)) >> 16; }
__device__ __forceinline__ float sigm(float x) { return __builtin_amdgcn_rcpf(1.f + __builtin_amdgcn_exp2f(x * -1.4426950408889634f)); }
__device__ __forceinline__ u32x4 pack8(f32x4 a, f32x4 b) { u32x4 w; w.x = pg8::cvt_pk_bf16(a[0], a[1]); w.y = pg8::cvt_pk_bf16(a[2], a[3]); w.z = pg8::cvt_pk_bf16(b[0], b[1]); w.w = pg8::cvt_pk_bf16(b[2], b[3]); return w; }
__device__ __forceinline__ float wave_sum(float v) {
#pragma unroll
    for (int o = 1; o < 64; o <<= 1) v += __shfl_xor(v, o);
    return v;
}

typedef float f32x2v __attribute__((ext_vector_type(2)));
__device__ __forceinline__ void stats_to(const f32x2v st, float& mean, float& rstd) {
    float inv = 1.f / DM; asm volatile("" : "+s"(inv));
    mean = st.x * inv; rstd = __builtin_amdgcn_rsqf(fmaxf(st.y * inv - mean * mean, 0.f) + LN_EPS);
}
struct EpiH {
    static constexpr bool PERM = true, AFTER_DRAIN = false;
    bf16* H; const float* rope; const float* stats; const float* cs; const float* bw; int ln;
    __device__ __forceinline__ void operator()(const f32x4 (&acc)[2][2][4][2], const pg8::Unit& u, int wr, int wc, int fr, int fq) const {
        const int colt = u.pn * 256, rowb = u.pm * 256 + wr * 64 + fr;
        const int act = (u.pn == 3 || u.pn == 4) ? 1 : (u.pn == 11 || u.pn == 12) ? 2 : (u.pn >= 13) ? 3 : 0;
        float mean[8], rstd[8];
#pragma unroll
        for (int r = 0; r < 8; ++r) { mean[r] = 0.f; rstd[r] = 1.f; }
        if (ln) {
            f32x2v st[8];
#pragma unroll
            for (int r = 0; r < 8; ++r) st[r] = *(const f32x2v*)(stats + 2 * (rowb + (r >> 2) * 128 + (r & 3) * 16));
#pragma unroll
            for (int r = 0; r < 8; ++r) stats_to(st[r], mean[r], rstd[r]);
        }
#pragma unroll
        for (int bj = 0; bj < 2; ++bj) {
            const int c0 = colt + bj * 128 + wc * 32 + 8 * fq;
            f32x4 cs0 = (f32x4){0.f, 0.f, 0.f, 0.f}, cs1 = cs0, bw0 = cs0, bw1 = cs0;
            if (ln) { cs0 = *(const f32x4*)(cs + c0); cs1 = *(const f32x4*)(cs + c0 + 4); bw0 = *(const f32x4*)(bw + c0); bw1 = *(const f32x4*)(bw + c0 + 4); }
            const bool ropet = (colt + bj * 128 < 640) && ((wc & 1) == 0);
#pragma unroll
            for (int r = 0; r < 8; ++r) {
                const int ai = r >> 2, m = r & 3, row = rowb + ai * 128 + m * 16;
                f32x4 v0 = acc[ai][bj][m][0], v1 = acc[ai][bj][m][1];
                if (ln) { v0 = (v0 - cs0 * mean[r]) * rstd[r] + bw0; v1 = (v1 - cs1 * mean[r]) * rstd[r] + bw1; }
                if (ropet) {
                    f32x4 p0, p1;
#pragma unroll
                    for (int i = 0; i < 4; ++i) { p0[i] = __shfl_xor(v0[i], 16); p1[i] = __shfl_xor(v1[i], 16); }
                    if (fq < 2) {
                        const float* rp = rope + (size_t)(row & (SEQ - 1)) * 16;
                        const f32x4 c0r = *(const f32x4*)rp, c1r = *(const f32x4*)(rp + 4), s0 = *(const f32x4*)(rp + 8), s1 = *(const f32x4*)(rp + 12);
                        if (fq == 0) { v0 = v0 * c0r - p0 * s0; v1 = v1 * c1r - p1 * s1; }
                        else         { v0 = v0 * c0r + p0 * s0; v1 = v1 * c1r + p1 * s1; }
                    }
                }
                if (u.pn < 2) { v0 = v0 * 0.18033688011112042f; v1 = v1 * 0.18033688011112042f; }
                if (act == 3) {
#pragma unroll
                    for (int i = 0; i < 4; ++i) { v0[i] = sigm(v0[i]); v1[i] = sigm(v1[i]); }
                } else if (act) {
                    const float sc = act == 1 ? 0.125f : 1.f;
#pragma unroll
                    for (int i = 0; i < 4; ++i) { v0[i] = v0[i] * sc * sigm(v0[i]); v1[i] = v1[i] * sc * sigm(v1[i]); }
                }
                *(u32x4*)(H + (size_t)row * HP + c0) = pack8(v0, v1);
            }
            asm volatile("" ::: "memory");
        }
    }
};
template <bool ADD> struct EpiMix {
    static constexpr bool PERM = true, AFTER_DRAIN = false;
    static constexpr int RB = 8;
    const bf16* Hg; bf16* MIX;
    __device__ __forceinline__ void operator()(const f32x4 (&acc)[2][2][4][2], const pg8::Unit& u, int wr, int wc, int fr, int fq) const {
        const int rowb = u.pm * 256 + wr * 64 + fr;
#pragma unroll
        for (int bj = 0; bj < 2; ++bj)
#pragma unroll
            for (int rb = 0; rb < 8; rb += RB) {
                const int c0 = u.pn * 256 + bj * 128 + wc * 32 + 8 * fq;
                u32x4 g[RB], o[RB];
#pragma unroll
                for (int r = 0; r < RB; ++r) { const int row = rowb + ((rb + r) >> 2) * 128 + ((rb + r) & 3) * 16;
                    g[r] = *(const u32x4*)(Hg + (size_t)row * HP + c0);
                    if (ADD) o[r] = *(const u32x4*)(MIX + (size_t)row * DM + c0); }
#pragma unroll
                for (int r = 0; r < RB; ++r) { const int ai = (rb + r) >> 2, m = (rb + r) & 3, row = rowb + ai * 128 + m * 16;
                    f32x4 v0 = acc[ai][bj][m][0], v1 = acc[ai][bj][m][1];
                    v0[0] *= bflo(g[r].x); v0[1] *= bfhi(g[r].x); v0[2] *= bflo(g[r].y); v0[3] *= bfhi(g[r].y);
                    v1[0] *= bflo(g[r].z); v1[1] *= bfhi(g[r].z); v1[2] *= bflo(g[r].w); v1[3] *= bfhi(g[r].w);
                    if (ADD) {
                        v0[0] += bflo(o[r].x); v0[1] += bfhi(o[r].x); v0[2] += bflo(o[r].y); v0[3] += bfhi(o[r].y);
                        v1[0] += bflo(o[r].z); v1[1] += bfhi(o[r].z); v1[2] += bflo(o[r].w); v1[3] += bfhi(o[r].w); }
                    *(u32x4*)(MIX + (size_t)row * DM + c0) = pack8(v0, v1);
                }
                asm volatile("" ::: "memory");
            }
    }
};
struct EpiRes {
    static constexpr bool PERM = true, AFTER_DRAIN = false;
    bf16* xb; int norm; const float* statsIn; const float* gIn; const float* bIn; float* statsOut;
    __device__ __forceinline__ void operator()(const f32x4 (&acc)[2][2][4][2], const pg8::Unit& u, int wr, int wc, int fr, int fq) const {
#pragma unroll
        for (int ai = 0; ai < 2; ++ai) {
            const int rowb = u.pm * 256 + ai * 128 + wr * 64 + fr;
            float s[4], q[4];
#pragma unroll
            for (int m = 0; m < 4; ++m) { s[m] = 0.f; q[m] = 0.f; }
            u32x4 xv[2][4]; f32x2v st[4];
#pragma unroll
            for (int m = 0; m < 4; ++m) {
#pragma unroll
                for (int bj = 0; bj < 2; ++bj) xv[bj][m] = *(const u32x4*)(xb + (size_t)(rowb + m * 16) * DM + u.pn * 256 + bj * 128 + wc * 32 + 8 * fq);
                if (norm) st[m] = *(const f32x2v*)(statsIn + 2 * (rowb + m * 16)); }
#pragma unroll
            for (int bj = 0; bj < 2; ++bj) {
                const int c0 = u.pn * 256 + bj * 128 + wc * 32 + 8 * fq;
                f32x4 g0 = (f32x4){1.f, 1.f, 1.f, 1.f}, g1 = g0, b0 = (f32x4){0.f, 0.f, 0.f, 0.f}, b1 = b0;
                if (norm) { g0 = *(const f32x4*)(gIn + c0); g1 = *(const f32x4*)(gIn + c0 + 4); b0 = *(const f32x4*)(bIn + c0); b1 = *(const f32x4*)(bIn + c0 + 4); }
#pragma unroll
                for (int m = 0; m < 4; ++m) { const u32x4 xw = xv[bj][m];
                    f32x4 x0 = (f32x4){bflo(xw.x), bfhi(xw.x), bflo(xw.y), bfhi(xw.y)}, x1 = (f32x4){bflo(xw.z), bfhi(xw.z), bflo(xw.w), bfhi(xw.w)};
                    if (norm) { float mean, rstd; stats_to(st[m], mean, rstd); x0 = (x0 - mean) * rstd * g0 + b0; x1 = (x1 - mean) * rstd * g1 + b1; }
                    const f32x4 o0 = x0 * ALPHA + acc[ai][bj][m][0], o1 = x1 * ALPHA + acc[ai][bj][m][1];
                    *(u32x4*)(xb + (size_t)(rowb + m * 16) * DM + c0) = pack8(o0, o1);
                    s[m] += ((o0[0] + o0[1]) + (o0[2] + o0[3])) + ((o1[0] + o1[1]) + (o1[2] + o1[3]));
                    q[m] += ((o0[0] * o0[0] + o0[1] * o0[1]) + (o0[2] * o0[2] + o0[3] * o0[3])) + ((o1[0] * o1[0] + o1[1] * o1[1]) + (o1[2] * o1[2] + o1[3] * o1[3]));
                }
            }
#pragma unroll
            for (int m = 0; m < 4; ++m) {
                float ss = s[m], qq = q[m];
                ss += __shfl_xor(ss, 16); ss += __shfl_xor(ss, 32); qq += __shfl_xor(qq, 16); qq += __shfl_xor(qq, 32);
                if (fq == 0) { atomicAdd(statsOut + 2 * (rowb + m * 16), ss); atomicAdd(statsOut + 2 * (rowb + m * 16) + 1, qq); }
            }
            asm volatile("" ::: "memory");
        }
    }
};
struct EpiFF1 {
    static constexpr bool PERM = true, AFTER_DRAIN = false;
    bf16* F; const float* stats; const float* cs; const float* bw;
    __device__ __forceinline__ void operator()(const f32x4 (&acc)[2][2][4][2], const pg8::Unit& u, int wr, int wc, int fr, int fq) const {
        const int rowb = u.pm * 256 + wr * 64 + fr;
        float mean[8], rstd[8];
        {
            f32x2v st[8];
#pragma unroll
            for (int r = 0; r < 8; ++r) st[r] = *(const f32x2v*)(stats + 2 * (rowb + (r >> 2) * 128 + (r & 3) * 16));
#pragma unroll
            for (int r = 0; r < 8; ++r) stats_to(st[r], mean[r], rstd[r]);
        }
#pragma unroll
        for (int bj = 0; bj < 2; ++bj) {
            const int c0 = u.pn * 256 + bj * 128 + wc * 32 + 8 * fq;
            const f32x4 cs0 = *(const f32x4*)(cs + c0), cs1 = *(const f32x4*)(cs + c0 + 4), bw0 = *(const f32x4*)(bw + c0), bw1 = *(const f32x4*)(bw + c0 + 4);
#pragma unroll
            for (int r = 0; r < 8; ++r) { const int ai = r >> 2, m = r & 3, row = rowb + ai * 128 + m * 16;
                f32x4 v0 = (acc[ai][bj][m][0] - cs0 * mean[r]) * rstd[r] + bw0, v1 = (acc[ai][bj][m][1] - cs1 * mean[r]) * rstd[r] + bw1;
#pragma unroll
                for (int i = 0; i < 4; ++i) { const float a = fmaxf(v0[i], 0.f), b = fmaxf(v1[i], 0.f); v0[i] = a * a; v1[i] = b * b; }
                *(u32x4*)(F + (size_t)row * DFF + c0) = pack8(v0, v1);
            }
            asm volatile("" ::: "memory");
        }
    }
};

__device__ __forceinline__ void transpose_item(const float* W, int K, int N, bf16* WT, LAS float* scr, int item, int lane, const float* gk, const float* bk, float* cs, float* bw) {
    const int nblk = N / 32, kb = item / nblk, nb = item % nblk, k0 = 64 * kb, n0 = 32 * nb;
    float csum = 0.f, bsum = 0.f;
#pragma unroll
    for (int i = 0; i < 32; ++i) { const int kk = 2 * i + (lane >> 5); float w = W[(size_t)(k0 + kk) * N + n0 + (lane & 31)];
        if (gk) { const float wg = w * gk[k0 + kk]; bsum += w * bk[k0 + kk]; w = wg; csum += __uint_as_float(f2bf(wg) << 16); }
        scr[kk * 33 + (lane & 31)] = w; }
    if (gk) { csum += __shfl_xor(csum, 32); bsum += __shfl_xor(bsum, 32); if (lane < 32) { atomicAdd(cs + n0 + lane, csum); atomicAdd(bw + n0 + lane, bsum); } }
    asm volatile("s_waitcnt lgkmcnt(0)" ::: "memory");
    const int c = lane & 7;
#pragma unroll
    for (int j = 0; j < 4; ++j) { const int n = (lane >> 3) + 8 * j; const LAS float* s = scr + (8 * c) * 33 + n;
        u32x4 o; o.x = pg8::cvt_pk_bf16(s[0 * 33], s[1 * 33]); o.y = pg8::cvt_pk_bf16(s[2 * 33], s[3 * 33]); o.z = pg8::cvt_pk_bf16(s[4 * 33], s[5 * 33]); o.w = pg8::cvt_pk_bf16(s[6 * 33], s[7 * 33]);
        *(u32x4*)(WT + (size_t)(n0 + n) * K + k0 + 8 * c) = o; }
    asm volatile("s_waitcnt lgkmcnt(0)" ::: "memory");
}

__device__ __forceinline__ void ln_final(const bf16* XB, const float* stats, float* out, const float* g, const float* b, int G, int cu) {
    int tid = threadIdx.x; asm volatile("" : "+v"(tid)); const int gid = cu * NTHR + tid, nthr = G * NTHR;
    for (int w = gid; w < MG * DM / 8; w += nthr) {
        const int row = w >> 7, c0 = (w & 127) * 8;
        const u32x4 xv = *(const u32x4*)(XB + (size_t)w * 8);
        float mean, rstd; stats_to(*(const f32x2v*)(stats + 2 * row), mean, rstd);
        const f32x4 g0 = *(const f32x4*)(g + c0), g1 = *(const f32x4*)(g + c0 + 4), b0 = *(const f32x4*)(b + c0), b1 = *(const f32x4*)(b + c0 + 4);
        const f32x4 x0 = (f32x4){bflo(xv.x), bfhi(xv.x), bflo(xv.y), bfhi(xv.y)}, x1 = (f32x4){bflo(xv.z), bfhi(xv.z), bflo(xv.w), bfhi(xv.w)};
        *(f32x4*)(out + (size_t)w * 8) = (x0 - mean) * rstd * g0 + b0;
        *(f32x4*)(out + (size_t)w * 8 + 4) = (x1 - mean) * rstd * g1 + b1;
    }
}

constexpr int AT_KP = 144  , AT_VP = 408  , AT_VOFF = 400 * AT_KP;
__device__ __forceinline__ void attn_phase(LAS unsigned char* lds, const bf16* H, bf16* OATT, const float* sink, int G, int cu) {
    int tid = threadIdx.x; asm volatile("" : "+v"(tid)); const int lane = tid & 63, wave = __builtin_amdgcn_readfirstlane(tid >> 6);
    const int fr = lane & 15, fq = lane >> 4;
    LAS unsigned char* ldsK = lds; LAS unsigned short* ldsV = (LAS unsigned short*)(lds + AT_VOFF);
    for (int unit = cu; unit < GSEQ * 32 * 2; unit += G) {
        const int seq = unit >> 6, nb = (unit >> 1) & 31, kvh = unit & 1;
        const int rowbase = seq * SEQ, kpos0 = nb * 128 - 128;
        const int r0 = 16 * wave;
        const size_t qrow = (size_t)rowbase + nb * 128 + r0 + fr;
        bf16x8 qall[4][2];
#pragma unroll
        for (int g = 0; g < 4; ++g) { qall[g][0] = *(const bf16x8*)(H + qrow * HP + (kvh * 4 + g) * 64 + fq * 8); qall[g][1] = *(const bf16x8*)(H + qrow * HP + (kvh * 4 + g) * 64 + 32 + fq * 8); }
        u32x4 kst[7], vst[7];
#pragma unroll
        for (int i = 0; i < 7; ++i) {
            const int c = tid + i * NTHR, ch = c / 400, r = c - ch * 400, pos = kpos0 + r;
            const bool ok = (c < 3200) && (r < 384) && (pos >= 0) && (pos < SEQ);
            kst[i] = (u32x4){0u, 0u, 0u, 0u}; vst[i] = (u32x4){0u, 0u, 0u, 0u};
            if (ok) { const bf16* src = H + (size_t)(rowbase + pos) * HP + kvh * 64 + ch * 8; kst[i] = *(const u32x4*)(src + C_AK); vst[i] = *(const u32x4*)(src + C_AV); }
        }
        __syncthreads();
#pragma unroll
        for (int i = 0; i < 7; ++i) {
            const int c = tid + i * NTHR, ch = c / 400, r = c - ch * 400;
            if (c < 3200) {
                *(LAS u32x4*)(ldsK + r * AT_KP + ch * 16) = kst[i];
                LAS unsigned short* vp = ldsV + (ch * 8) * AT_VP + r; const u32x4 vv = vst[i];
                vp[0 * AT_VP] = (unsigned short)(vv.x & 0xffffu); vp[1 * AT_VP] = (unsigned short)(vv.x >> 16);
                vp[2 * AT_VP] = (unsigned short)(vv.y & 0xffffu); vp[3 * AT_VP] = (unsigned short)(vv.y >> 16);
                vp[4 * AT_VP] = (unsigned short)(vv.z & 0xffffu); vp[5 * AT_VP] = (unsigned short)(vv.z >> 16);
                vp[6 * AT_VP] = (unsigned short)(vv.w & 0xffffu); vp[7 * AT_VP] = (unsigned short)(vv.w >> 16);
            }
        }
        __syncthreads();
#pragma unroll
        for (int g = 0; g < 4; ++g) {
            const int head = kvh * 4 + g;
            bf16x8 qf[2]; qf[0] = qall[g][0]; qf[1] = qall[g][1];
            f32x4 s[18];
#pragma unroll
            for (int kt = 0; kt < 18; ++kt) {
                s[kt] = (f32x4){0.f, 0.f, 0.f, 0.f};
#pragma unroll
                for (int kk = 0; kk < 2; ++kk) {
                    const bf16x8 a = *(const LAS bf16x8*)(ldsK + (r0 + kt * 16 + fr) * AT_KP + kk * 64 + fq * 16);
                    s[kt] = __builtin_amdgcn_mfma_f32_16x16x32_bf16(a, qf[kk], s[kt], 0, 0, 0);
                }
            }
            const float sk = sink[head] * 1.4426950408889634f;
            float mx = sk;
            if (nb == 0 || nb == 31) {
#pragma unroll
                for (int kt = 0; kt < 18; ++kt)
#pragma unroll
                    for (int i = 0; i < 4; ++i) {
                        const int kl = r0 + kt * 16 + 4 * fq + i, rel = kt * 16 + 4 * fq + i - 128 - fr, ap = kpos0 + kl;
                        const bool ok = (rel >= -128) && (rel <= 128) && (ap >= 0) && (ap < SEQ);
                        const float v = ok ? s[kt][i] : -INFINITY;
                        s[kt][i] = v; mx = fmaxf(mx, v);
                    }
            } else {
#pragma unroll
                for (int kt = 0; kt < 18; ++kt)
#pragma unroll
                    for (int i = 0; i < 4; ++i) {
                        float v = s[kt][i];
                        if (kt == 0 || kt >= 16) { const int rel = kt * 16 + 4 * fq + i - 128 - fr; v = ((rel >= -128) && (rel <= 128)) ? v : -INFINITY; }
                        s[kt][i] = v; mx = fmaxf(mx, v);
                    }
            }
            mx = fmaxf(mx, __shfl_xor(mx, 16)); mx = fmaxf(mx, __shfl_xor(mx, 32));
            float sum = 0.f;
#pragma unroll
            for (int kt = 0; kt < 18; ++kt)
#pragma unroll
                for (int i = 0; i < 4; ++i) { const float p = __builtin_amdgcn_exp2f(s[kt][i] - mx); s[kt][i] = p; sum += p; }
            sum += __shfl_xor(sum, 16); sum += __shfl_xor(sum, 32);
            const float inv = 1.f / (sum + __builtin_amdgcn_exp2f(sk - mx));
            f32x4 o[4];
#pragma unroll
            for (int dt = 0; dt < 4; ++dt) o[dt] = (f32x4){0.f, 0.f, 0.f, 0.f};
#pragma unroll
            for (int kb = 0; kb < 9; ++kb) {
                const bf16x8 pb = __builtin_bit_cast(bf16x8, pack8(s[2 * kb], s[2 * kb + 1]));
#pragma unroll
                for (int dt = 0; dt < 4; ++dt) {
                    const LAS unsigned short* vp = ldsV + (dt * 16 + fr) * AT_VP + r0 + kb * 32 + 4 * fq;
                    const u32x2 lo = *(const LAS u32x2*)vp, hi = *(const LAS u32x2*)(vp + 16);
                    const bf16x8 a = __builtin_bit_cast(bf16x8, (u32x4){lo.x, lo.y, hi.x, hi.y});
                    o[dt] = __builtin_amdgcn_mfma_f32_16x16x32_bf16(a, pb, o[dt], 0, 0, 0);
                }
            }
#pragma unroll
            for (int dt = 0; dt < 4; ++dt) {
                u32x2 w; w.x = pg8::cvt_pk_bf16(o[dt][0] * inv, o[dt][1] * inv); w.y = pg8::cvt_pk_bf16(o[dt][2] * inv, o[dt][3] * inv);
                *(u32x2*)(OATT + qrow * 512 + head * 64 + dt * 16 + 4 * fq) = w;
            }
        }
    }
    __syncthreads();
}

constexpr int HG_P = 72;
constexpr int HL_T0 = 2048, HL_TSZ = 64 * HG_P * 2  ;
constexpr int HG_ITEMS = GSEQ * 64 * 8;
struct HgIn { u32x4 f0, f1, q0, q1, v; };
template <bool WITHQ> __device__ __forceinline__ void hg_load(HgIn& r, const bf16* H, int item, int dir, int dq, int wave, int lane) {
    const int seq = item >> 9, chunk = (item >> 3) & 63, head = item & 7;
    const size_t rowbase = (size_t)seq * SEQ + chunk * 64;
    const int tok = dir ? 63 - lane : lane;
    const bf16* hr = H + (rowbase + tok) * HP + head * 64 + 16 * dq;
    r.f0 = *(const u32x4*)(hr + C_HFF + dir * 512); r.f1 = *(const u32x4*)(hr + C_HFF + dir * 512 + 8);
    if (WITHQ) { r.q0 = *(const u32x4*)(hr + C_HQ); r.q1 = *(const u32x4*)(hr + C_HQ + 8); }
    r.v = *(const u32x4*)(H + (rowbase + lane) * HP + C_HI + head * 64 + 8 * wave);
}
__device__ __forceinline__ float bfel(const u32x4& a, const u32x4& b, int i) {
    const unsigned w = (i < 8) ? a[(i >> 1) & 3] : b[(i >> 1) & 3];
    return (i & 1) ? bfhi(w) : bflo(w);
}
__device__ __forceinline__ float dpp_shr(float v, int  ) { return v; }
__device__ __forceinline__ float wave_scan(float v, int lane) {
    v += __int_as_float(__builtin_amdgcn_update_dpp(0, __float_as_int(v), 0x111, 0xF, 0xF, false));
    v += __int_as_float(__builtin_amdgcn_update_dpp(0, __float_as_int(v), 0x112, 0xF, 0xF, false));
    v += __int_as_float(__builtin_amdgcn_update_dpp(0, __float_as_int(v), 0x114, 0xF, 0xF, false));
    v += __int_as_float(__builtin_amdgcn_update_dpp(0, __float_as_int(v), 0x118, 0xF, 0xF, false));
    v += __int_as_float(__builtin_amdgcn_update_dpp(0, __float_as_int(v), 0x142, 0xA, 0xF, false));
    v += __int_as_float(__builtin_amdgcn_update_dpp(0, __float_as_int(v), 0x143, 0xC, 0xF, false));
    return v;
}
__device__ __forceinline__ float lane_bcast(float v, int l) { return __int_as_float(__builtin_amdgcn_readlane(__float_as_int(v), l)); }
__device__ __forceinline__ unsigned short bf1(float x) { return (unsigned short)(pg8::cvt_pk_bf16(x, x) & 0xffffu); }

constexpr int HL_IN1 = 32768;
struct HgLines1 { u32x4 p[3]; };
__device__ __forceinline__ void hg_lines1_load(HgLines1& r, const bf16* H, int item, int tid) {
    const int seq = item >> 9, chunk = (item >> 3) & 63, head = item & 7, row = tid >> 3, piece = tid & 7;
    const bf16* hr = H + ((size_t)seq * SEQ + chunk * 64 + row) * HP + head * 64 + piece * 8;
    r.p[0] = *(const u32x4*)(hr + C_HFF); r.p[1] = *(const u32x4*)(hr + C_HFF + 512); r.p[2] = *(const u32x4*)(hr + C_HI);
}
__device__ __forceinline__ void hg_lines1_store(const HgLines1& r, LAS unsigned char* in, int tid) {
    LAS unsigned char* d = in + (tid >> 3) * 144 + (tid & 7) * 16;
#pragma unroll
    for (int a = 0; a < 3; ++a) *(LAS u32x4*)(d + a * 9216) = r.p[a];
}
__device__ __forceinline__ void hgrn_pass1(LAS unsigned char* lds, const bf16* H, bf16* SB, float* DEC, const float* lbp, int layer, int G, int cu) {
    int tid = threadIdx.x; asm volatile("" : "+v"(tid)); const int lane = tid & 63, wave = __builtin_amdgcn_readfirstlane(tid >> 6);
    const int fr = lane & 15, fq = lane >> 4, dir = wave >> 2, dq = wave & 3;
    const int tok = dir ? 63 - lane : lane;
    LAS unsigned short* KT = (LAS unsigned short*)(lds + HL_T0 + dir * HL_TSZ);
    LAS unsigned short* VT = (LAS unsigned short*)(lds + HL_T0 + 2 * HL_TSZ);
    LAS unsigned char* IN = lds + HL_IN1;
    HgIn cur; HgLines1 nl;
    if (cu < HG_ITEMS) { hg_lines1_load(nl, H, cu, tid); hg_lines1_store(nl, IN, tid); }
    __syncthreads();
    for (int item = cu; item < HG_ITEMS; item += G) {
        const int seq = item >> 9, chunk = (item >> 3) & 63, head = item & 7;
        const int gcol = dir * 512 + head * 64 + 16 * dq;
        {
            const LAS unsigned char* rf = IN + dir * 9216 + tok * 144 + dq * 32;
            cur.f0 = *(const LAS u32x4*)rf; cur.f1 = *(const LAS u32x4*)(rf + 16);
            cur.v = *(const LAS u32x4*)(IN + 2 * 9216 + lane * 144 + wave * 16);
        }
        float b[16], kk[16];
        f32x4 lbq[4];
#pragma unroll
        for (int i = 0; i < 4; ++i) lbq[i] = *(const f32x4*)(lbp + layer * 1024 + gcol + 4 * i);
#pragma unroll
        for (int i = 0; i < 16; ++i) {
            const float lb = lbq[i >> 2][i & 3];
            const float f = lb + (1.f - lb) * sigm(bfel(cur.f0, cur.f1, i));
            kk[i] = 1.f - f; b[i] = wave_scan(__builtin_amdgcn_logf(f), lane);
        }
        const u32x4 vv = cur.v;
        const int chain = (seq * 8 + head) * 2 + dir, cidx = dir ? 63 - chunk : chunk;
        float dcy[16];
#pragma unroll
        for (int i = 0; i < 16; ++i) {
            const float blast = lane_bcast(b[i], 63);
            KT[(16 * dq + i) * HG_P + tok] = bf1(kk[i] * __builtin_amdgcn_exp2f(blast - b[i]));
            dcy[i] = blast;
        }
        if (lane == 63) {
            float* dp = DEC + (size_t)(chain * 64 + cidx) * 64 + 16 * dq;
#pragma unroll
            for (int i = 0; i < 4; ++i) *(f32x4*)(dp + 4 * i) = (f32x4){dcy[4 * i], dcy[4 * i + 1], dcy[4 * i + 2], dcy[4 * i + 3]};
        }
        {
            LAS unsigned short* vp = VT + (8 * wave) * HG_P + lane;
            vp[0 * HG_P] = (unsigned short)(vv.x & 0xffffu); vp[1 * HG_P] = (unsigned short)(vv.x >> 16);
            vp[2 * HG_P] = (unsigned short)(vv.y & 0xffffu); vp[3 * HG_P] = (unsigned short)(vv.y >> 16);
            vp[4 * HG_P] = (unsigned short)(vv.z & 0xffffu); vp[5 * HG_P] = (unsigned short)(vv.z >> 16);
            vp[6 * HG_P] = (unsigned short)(vv.w & 0xffffu); vp[7 * HG_P] = (unsigned short)(vv.w >> 16);
        }
        __syncthreads();
        hg_lines1_load(nl, H, item + G < HG_ITEMS ? item + G : item, tid);
        f32x4 acc[4];
#pragma unroll
        for (int et = 0; et < 4; ++et) acc[et] = (f32x4){0.f, 0.f, 0.f, 0.f};
#pragma unroll
        for (int k2 = 0; k2 < 2; ++k2) {
            const bf16x8 a = *(const LAS bf16x8*)(KT + (16 * dq + fr) * HG_P + k2 * 32 + fq * 8);
#pragma unroll
            for (int et = 0; et < 4; ++et) {
                const bf16x8 bb = *(const LAS bf16x8*)(VT + (16 * et + fr) * HG_P + k2 * 32 + fq * 8);
                acc[et] = __builtin_amdgcn_mfma_f32_16x16x32_bf16(a, bb, acc[et], 0, 0, 0);
            }
        }
        bf16* sb = SB + (size_t)(chain * 64 + cidx) * 4096;
#pragma unroll
        for (int et = 0; et < 4; ++et) { u32x2 w; w.x = pg8::cvt_pk_bf16(acc[et][0], acc[et][1]); w.y = pg8::cvt_pk_bf16(acc[et][2], acc[et][3]); *(u32x2*)(sb + (16 * et + fr) * 64 + 16 * dq + 4 * fq) = w; }
        hg_lines1_store(nl, IN, tid);
        __syncthreads();
    }
    __syncthreads();
}
__device__ __forceinline__ void hgrn_prefix(bf16* SB, const float* DEC, int G, int cu) {
    int tid = threadIdx.x; asm volatile("" : "+v"(tid)); const int gid = cu * NTHR + tid, nthr = G * NTHR;
    for (int w = gid; w < GSEQ * 8 * 2 * 512; w += nthr) {
        const int chain = w >> 9, v = w & 511, d0 = (v & 7) * 8;
        u32x4* p = (u32x4*)(SB + (size_t)chain * 64 * 4096) + v;
        const f32x4* dp = (const f32x4*)(DEC + (size_t)chain * 64 * 64 + d0);
        f32x4 c0 = (f32x4){0.f, 0.f, 0.f, 0.f}, c1 = (f32x4){0.f, 0.f, 0.f, 0.f};
#pragma unroll 16
        for (int c = 0; c < 64; ++c) {
            const u32x4 t = p[(size_t)c * 512]; const f32x4 l0 = dp[c * 16], l1 = dp[c * 16 + 1];
            p[(size_t)c * 512] = pack8(c0, c1);
            const f32x4 t0 = (f32x4){bflo(t.x), bfhi(t.x), bflo(t.y), bfhi(t.y)}, t1 = (f32x4){bflo(t.z), bfhi(t.z), bflo(t.w), bfhi(t.w)};
            const f32x4 e0 = (f32x4){__builtin_amdgcn_exp2f(l0[0]), __builtin_amdgcn_exp2f(l0[1]), __builtin_amdgcn_exp2f(l0[2]), __builtin_amdgcn_exp2f(l0[3])}, e1 = (f32x4){__builtin_amdgcn_exp2f(l1[0]), __builtin_amdgcn_exp2f(l1[1]), __builtin_amdgcn_exp2f(l1[2]), __builtin_amdgcn_exp2f(l1[3])};
            c0 = e0 * c0 + t0; c1 = e1 * c1 + t1;
        }
    }
}
constexpr int HL_OB = HL_T0 + 7 * HL_TSZ;
constexpr int HL_IN = HL_OB + 64 * 68 * 4;
static_assert(HL_IN + 5 * HL_TSZ <= 131072, "HGRN LDS map");
struct HgLines { u32x4 p[5]; };
__device__ __forceinline__ void hg_lines_load(HgLines& r, const bf16* H, int item, int tid) {
    const int seq = item >> 9, chunk = (item >> 3) & 63, head = item & 7, row = tid >> 3, piece = tid & 7;
    const bf16* hr = H + ((size_t)seq * SEQ + chunk * 64 + row) * HP + head * 64 + piece * 8;
    r.p[0] = *(const u32x4*)(hr + C_HFF); r.p[1] = *(const u32x4*)(hr + C_HFF + 512); r.p[2] = *(const u32x4*)(hr + C_HQ); r.p[3] = *(const u32x4*)(hr + C_HI); r.p[4] = *(const u32x4*)(hr + C_HG);
}
__device__ __forceinline__ void hg_lines_store(const HgLines& r, LAS unsigned char* in, int tid) {
    LAS unsigned char* d = in + (tid >> 3) * 144 + (tid & 7) * 16;
#pragma unroll
    for (int a = 0; a < 5; ++a) *(LAS u32x4*)(d + a * HL_TSZ) = r.p[a];
}
__device__ __forceinline__ void hgrn_pass3(LAS unsigned char* lds, const bf16* H, const bf16* SB, bf16* OHG, const float* lbp, const float* ng, int layer, int G, int cu) {
    int tid = threadIdx.x; asm volatile("" : "+v"(tid)); const int lane = tid & 63, wave = __builtin_amdgcn_readfirstlane(tid >> 6);
    const int fr = lane & 15, fq = lane >> 4, dir = wave >> 2, dq = wave & 3;
    const int tok = dir ? 63 - lane : lane;
    LAS unsigned short* QT = (LAS unsigned short*)(lds + HL_T0 + (dir * 3 + 0) * HL_TSZ);
    LAS unsigned short* QS = (LAS unsigned short*)(lds + HL_T0 + (dir * 3 + 1) * HL_TSZ);
    LAS unsigned short* KT = (LAS unsigned short*)(lds + HL_T0 + (dir * 3 + 2) * HL_TSZ);
    LAS unsigned short* VT = (LAS unsigned short*)(lds + HL_T0 + 6 * HL_TSZ);
    LAS float* OB = (LAS float*)(lds + HL_OB);
    const int j = dq, tl = 16 * j + fr;
    f32x4 ngv[4];
#pragma unroll
    for (int et = 0; et < 4; ++et) ngv[et] = *(const f32x4*)(ng + 16 * et + 4 * fq);
    LAS unsigned char* IN = lds + HL_IN;
    HgIn cur; HgLines nl;
    if (cu < HG_ITEMS) { hg_lines_load(nl, H, cu, tid); hg_lines_store(nl, IN, tid); }
    __syncthreads();
    for (int item = cu; item < HG_ITEMS; item += G) {
        const int seq = item >> 9, chunk = (item >> 3) & 63, head = item & 7;
        const size_t rowbase = (size_t)seq * SEQ + chunk * 64;
        const int gcol = dir * 512 + head * 64 + 16 * dq;
        const int chain = (seq * 8 + head) * 2 + dir, cidx = dir ? 63 - chunk : chunk;
        const bf16* sb = SB + (size_t)(chain * 64 + cidx) * 4096;
        bf16x8 st[2][4];
#pragma unroll
        for (int k2 = 0; k2 < 2; ++k2)
#pragma unroll
            for (int et = 0; et < 4; ++et) st[k2][et] = *(const bf16x8*)(sb + (16 * et + fr) * 64 + k2 * 32 + fq * 8);
        {
            const LAS unsigned char* rf = IN + dir * HL_TSZ + tok * 144 + dq * 32;
            const LAS unsigned char* rq = IN + 2 * HL_TSZ + tok * 144 + dq * 32;
            cur.f0 = *(const LAS u32x4*)rf; cur.f1 = *(const LAS u32x4*)(rf + 16);
            cur.q0 = *(const LAS u32x4*)rq; cur.q1 = *(const LAS u32x4*)(rq + 16);
            cur.v = *(const LAS u32x4*)(IN + 3 * HL_TSZ + lane * 144 + wave * 16);
        }
        u32x2 hgw[4];
#pragma unroll
        for (int et = 0; et < 4; ++et) hgw[et] = *(const LAS u32x2*)(IN + 4 * HL_TSZ + tl * 144 + (16 * et + 4 * fq) * 2);
        float b[16], kk[16], qq[16];
        f32x4 lbq[4];
#pragma unroll
        for (int i = 0; i < 4; ++i) lbq[i] = *(const f32x4*)(lbp + layer * 1024 + gcol + 4 * i);
#pragma unroll
        for (int i = 0; i < 16; ++i) {
            const float lb = lbq[i >> 2][i & 3];
            const float f = lb + (1.f - lb) * sigm(bfel(cur.f0, cur.f1, i));
            kk[i] = 1.f - f; qq[i] = bfel(cur.q0, cur.q1, i); b[i] = wave_scan(__builtin_amdgcn_logf(f), lane);
        }
        const u32x4 vv = cur.v;
        float qt[16], qs[16], kt[16];
#pragma unroll
        for (int i = 0; i < 16; ++i) {
            const float bref = lane_bcast(b[i], 31);
            const float dcl = __builtin_amdgcn_fmed3f(b[i] - bref, -115.f, 115.f);
            qt[i] = qq[i] * __builtin_amdgcn_exp2f(dcl);
            qs[i] = qq[i] * __builtin_amdgcn_exp2f(b[i]);
            kt[i] = kk[i] * __builtin_amdgcn_exp2f(-dcl);
        }
        {
            const int o = tok * HG_P + 16 * dq;
            *(LAS u32x4*)(QT + o) = pack8((f32x4){qt[0], qt[1], qt[2], qt[3]}, (f32x4){qt[4], qt[5], qt[6], qt[7]});
            *(LAS u32x4*)(QT + o + 8) = pack8((f32x4){qt[8], qt[9], qt[10], qt[11]}, (f32x4){qt[12], qt[13], qt[14], qt[15]});
            *(LAS u32x4*)(QS + o) = pack8((f32x4){qs[0], qs[1], qs[2], qs[3]}, (f32x4){qs[4], qs[5], qs[6], qs[7]});
            *(LAS u32x4*)(QS + o + 8) = pack8((f32x4){qs[8], qs[9], qs[10], qs[11]}, (f32x4){qs[12], qs[13], qs[14], qs[15]});
            *(LAS u32x4*)(KT + o) = pack8((f32x4){kt[0], kt[1], kt[2], kt[3]}, (f32x4){kt[4], kt[5], kt[6], kt[7]});
            *(LAS u32x4*)(KT + o + 8) = pack8((f32x4){kt[8], kt[9], kt[10], kt[11]}, (f32x4){kt[12], kt[13], kt[14], kt[15]});
            LAS unsigned short* vp = VT + (8 * wave) * HG_P + lane;
            vp[0 * HG_P] = (unsigned short)(vv.x & 0xffffu); vp[1 * HG_P] = (unsigned short)(vv.x >> 16);
            vp[2 * HG_P] = (unsigned short)(vv.y & 0xffffu); vp[3 * HG_P] = (unsigned short)(vv.y >> 16);
            vp[4 * HG_P] = (unsigned short)(vv.z & 0xffffu); vp[5 * HG_P] = (unsigned short)(vv.z >> 16);
            vp[6 * HG_P] = (unsigned short)(vv.w & 0xffffu); vp[7 * HG_P] = (unsigned short)(vv.w >> 16);
        }
        __syncthreads();
        hg_lines_load(nl, H, item + G < HG_ITEMS ? item + G : item, tid);
        bf16x8 qf[2];
        qf[0] = *(const LAS bf16x8*)(QT + tl * HG_P + fq * 8); qf[1] = *(const LAS bf16x8*)(QT + tl * HG_P + 32 + fq * 8);
        f32x4 as[4];
#pragma unroll
        for (int s4 = 0; s4 < 4; ++s4) {
            as[s4] = (f32x4){0.f, 0.f, 0.f, 0.f};
#pragma unroll
            for (int k2 = 0; k2 < 2; ++k2) {
                const bf16x8 a = *(const LAS bf16x8*)(KT + (16 * s4 + fr) * HG_P + k2 * 32 + fq * 8);
                as[s4] = __builtin_amdgcn_mfma_f32_16x16x32_bf16(a, qf[k2], as[s4], 0, 0, 0);
            }
#pragma unroll
            for (int i = 0; i < 4; ++i) { const int sidx = 16 * s4 + 4 * fq + i; const bool keep = dir ? (sidx >= tl) : (sidx <= tl); as[s4][i] = keep ? as[s4][i] : 0.f; }
        }
        f32x4 o[4];
#pragma unroll
        for (int et = 0; et < 4; ++et) o[et] = (f32x4){0.f, 0.f, 0.f, 0.f};
#pragma unroll
        for (int kb = 0; kb < 2; ++kb) {
            const bf16x8 pb = __builtin_bit_cast(bf16x8, pack8(as[2 * kb], as[2 * kb + 1]));
#pragma unroll
            for (int et = 0; et < 4; ++et) {
                const LAS unsigned short* vp = VT + (16 * et + fr) * HG_P + kb * 32 + 4 * fq;
                const u32x2 lo = *(const LAS u32x2*)vp, hi = *(const LAS u32x2*)(vp + 16);
                const bf16x8 a = __builtin_bit_cast(bf16x8, (u32x4){lo.x, lo.y, hi.x, hi.y});
                o[et] = __builtin_amdgcn_mfma_f32_16x16x32_bf16(a, pb, o[et], 0, 0, 0);
            }
        }
#pragma unroll
        for (int k2 = 0; k2 < 2; ++k2) {
            const bf16x8 bq = *(const LAS bf16x8*)(QS + tl * HG_P + k2 * 32 + fq * 8);
#pragma unroll
            for (int et = 0; et < 4; ++et) {
                o[et] = __builtin_amdgcn_mfma_f32_16x16x32_bf16(st[k2][et], bq, o[et], 0, 0, 0);
            }
        }
        if (dir == 1) {
#pragma unroll
            for (int et = 0; et < 4; ++et) *(LAS f32x4*)(OB + tl * 68 + 16 * et + 4 * fq) = o[et];
        }
        hg_lines_store(nl, IN, tid);
        __syncthreads();
        if (dir == 0) {
            float ss = 0.f;
#pragma unroll
            for (int et = 0; et < 4; ++et) { o[et] = o[et] + *(const LAS f32x4*)(OB + tl * 68 + 16 * et + 4 * fq); ss += (o[et][0] * o[et][0] + o[et][1] * o[et][1]) + (o[et][2] * o[et][2] + o[et][3] * o[et][3]); }
            ss += __shfl_xor(ss, 16); ss += __shfl_xor(ss, 32);
            const float r = 1.f / sqrtf(ss * (1.f / 64.f) + RMS_EPS);
            const size_t row = rowbase + tl;
#pragma unroll
            for (int et = 0; et < 4; ++et) {
                const int e0 = 16 * et + 4 * fq;
                const f32x4 g4 = ngv[et];
                const float h0 = bflo(hgw[et].x), h1 = bfhi(hgw[et].x), h2 = bflo(hgw[et].y), h3 = bfhi(hgw[et].y);
                const float y0 = o[et][0] * r * g4[0] * h0, y1 = o[et][1] * r * g4[1] * h1;
                const float y2 = o[et][2] * r * g4[2] * h2, y3 = o[et][3] * r * g4[3] * h3;
                u32x2 w; w.x = pg8::cvt_pk_bf16(y0, y1); w.y = pg8::cvt_pk_bf16(y2, y3);
                *(u32x2*)(OHG + row * 512 + head * 64 + e0) = w;
            }
        }
    }
    __syncthreads();
}

#define XB_TMO      128
#define XB_XCNT(j)  (256  + 64 * (j))
#define XB_XSUB(j)  (1280 + 64 * (j))
#define XB_XGEN(j)  (2304 + 64 * (j))
#define XB_TOP      3328
#define XB_TOPGEN   3392
#define XCD_BAR_WORDS 3456
#define XB_SPIN_CAP (1u << 18)

__device__ __forceinline__ unsigned xb_ld(unsigned* p)              { return __hip_atomic_load(p, __ATOMIC_RELAXED, __HIP_MEMORY_SCOPE_AGENT); }
__device__ __forceinline__ unsigned xb_add(unsigned* p, unsigned v) { return __hip_atomic_fetch_add(p, v, __ATOMIC_RELAXED, __HIP_MEMORY_SCOPE_AGENT); }
__device__ __forceinline__ unsigned xb_xcc_id() { return (unsigned)__builtin_amdgcn_s_getreg((3 << 11) | 20) & 0xFu; }
#define XB_SPIN(cond, bar) do { unsigned _sp = 0; while (cond) { __builtin_amdgcn_s_sleep(1); \
    if ((++_sp & 255u) == 0u) { if (xb_ld(&(bar)[XB_TMO])) break; if (_sp > XB_SPIN_CAP) { atomicAdd(&(bar)[XB_TMO], 1u); break; } } } } while (0)

struct XcdBarrier {
    unsigned* bar; unsigned x;
    volatile LAS unsigned* st;
};

__device__ __forceinline__ XcdBarrier xcd_barrier_post(unsigned* bar, volatile LAS unsigned* st) {
    XcdBarrier b; b.bar = bar; b.x = xb_xcc_id(); b.st = st;
    if (threadIdx.x == 0) (void)xb_add(&bar[XB_XCNT(b.x)], 1u);
    return b;
}
__device__ __forceinline__ void xcd_barrier_complete(unsigned* bar, unsigned x, unsigned& nloc, unsigned& nx) {
    const unsigned G = gridDim.x * gridDim.y * gridDim.z;
    unsigned sum, cnt, mine, sp = 0u;
    for (;;) {
        sum = 0u; cnt = 0u; mine = 0u;
#pragma unroll
        for (unsigned j = 0; j < 16; ++j) { const unsigned c = xb_ld(&bar[XB_XCNT(j)]); sum += c; cnt += (c > 0u) ? 1u : 0u; mine = (j == x) ? c : mine; }
        if (sum == G) break;
        __builtin_amdgcn_s_sleep(1);
        if ((++sp & 255u) == 0u) { if (xb_ld(&bar[XB_TMO])) break; if (sp > XB_SPIN_CAP) { atomicAdd(&bar[XB_TMO], 1u); break; } }
    }
    nloc = mine > 0u ? mine : 1u; nx = cnt > 0u ? cnt : 1u;
}

__device__ __forceinline__ void xcd_barrier(const XcdBarrier& b) {
    asm volatile("s_waitcnt vmcnt(0)" ::: "memory");
    __syncthreads();
    if (threadIdx.x == 0) {
        unsigned* bar = b.bar; asm volatile("" : "+s"(bar));
        __builtin_amdgcn_s_waitcnt(0);
        unsigned nloc = b.st[0], nx = b.st[1];
        if (nloc == 0u) { xcd_barrier_complete(bar, b.x, nloc, nx); b.st[0] = nloc; b.st[1] = nx; }
        const unsigned old = xb_add(&bar[XB_XSUB(b.x)], 1u);
        const unsigned gen = old / nloc;
        if (old + 1u == (gen + 1u) * nloc) {
            __builtin_amdgcn_fence(__ATOMIC_RELEASE, "agent");
            asm volatile("s_waitcnt vmcnt(0)" ::: "memory");
            const unsigned og = xb_add(&bar[XB_TOP], 1u);
            const unsigned tg = og / nx;
            if (og + 1u == (tg + 1u) * nx) xb_add(&bar[XB_TOPGEN], 1u);
            else XB_SPIN(xb_ld(&bar[XB_TOPGEN]) == tg, bar);
            __builtin_amdgcn_fence(__ATOMIC_ACQUIRE, "agent");
            xb_add(&bar[XB_XGEN(b.x)], 1u);
            asm volatile("s_waitcnt vmcnt(0)" ::: "memory");
        } else {
            XB_SPIN(xb_ld(&bar[XB_XGEN(b.x)]) == gen, bar);
            __builtin_amdgcn_fence(__ATOMIC_ACQUIRE, "agent");
            asm volatile("s_waitcnt vmcnt(0)" ::: "memory");
        }
    }
    __syncthreads();
}

struct Args { const float* xin[2]; const float *w_in, *sink, *lb, *ng, *wpa, *wph, *wout, *ln1g, *ln1b, *ff1, *ff2, *ln2g, *ln2b; float* out; unsigned char* ws; };

__global__ void __launch_bounds__(NTHR, 2) fwd_kernel(Args a) {
    extern __shared__ __attribute__((aligned(16))) unsigned char lds_raw[];
    LAS unsigned char* lds = (LAS unsigned char*)lds_raw;
    cg::grid_group grid = cg::this_grid();
    const int G = gridDim.x, cu = blockIdx.x;
    volatile LAS unsigned* bst = (volatile LAS unsigned*)(lds + 131072 + 64);
    if (threadIdx.x < 2) bst[threadIdx.x] = 0u;
    __syncthreads();
    const XcdBarrier bar = xcd_barrier_post((unsigned*)a.ws, bst);
#define WSQ(T, off) ((T)({ unsigned char* p_ = a.ws; asm volatile("" : "+s"(p_)); p_ + (off); }))

    {
        int tid = threadIdx.x; asm volatile("" : "+v"(tid)); const int lane = tid & 63, wave = __builtin_amdgcn_readfirstlane(tid >> 6);
        const int gw = cu * 8 + wave, NGW = G * 8, gid = cu * NTHR + tid, nthr = G * NTHR;
        LAS float* scr = (LAS float*)(lds + wave * 16384);
        unsigned char* ws = a.ws;
        constexpr int I_IN = 16 * 168, I_PA = 8 * 32, I_OUT = 16 * 32, I_F1 = 16 * 128, I_F2 = 64 * 32;
        constexpr int I_L = I_IN + 2 * I_PA + I_OUT + I_F1 + I_F2;
        for (int it = gw; it < 2 * I_L; it += NGW) {
            const int l = it / I_L; int r = it - l * I_L;
            unsigned char* wl = ws + WS_W + (size_t)l * WS_WL;
            if (r < I_IN) { if (l == 0) transpose_item(a.w_in, DM, HP, (bf16*)wl, scr, r, lane, nullptr, nullptr, nullptr, nullptr);
                              else transpose_item(a.w_in + (size_t)DM * HP, DM, HP, (bf16*)wl, scr, r, lane, a.ln2g, a.ln2b, (float*)(ws + WS_CSIN), (float*)(ws + WS_BWIN)); continue; } r -= I_IN;
            if (r < I_PA) { transpose_item(a.wpa + (size_t)l * 512 * DM, 512, DM, (bf16*)(wl + WO_PA), scr, r, lane, nullptr, nullptr, nullptr, nullptr); continue; } r -= I_PA;
            if (r < I_PA) { transpose_item(a.wph + (size_t)l * 512 * DM, 512, DM, (bf16*)(wl + WO_PH), scr, r, lane, nullptr, nullptr, nullptr, nullptr); continue; } r -= I_PA;
            if (r < I_OUT) { transpose_item(a.wout + (size_t)l * DM * DM, DM, DM, (bf16*)(wl + WO_OUT), scr, r, lane, nullptr, nullptr, nullptr, nullptr); continue; } r -= I_OUT;
            if (r < I_F1) { transpose_item(a.ff1 + (size_t)l * DM * DFF, DM, DFF, (bf16*)(wl + WO_FF1), scr, r, lane, a.ln1g + l * DM, a.ln1b + l * DM, (float*)(ws + WS_CS1) + l * DFF, (float*)(ws + WS_BW1) + l * DFF); continue; } r -= I_F1;
            transpose_item(a.ff2 + (size_t)l * DFF * DM, DFF, DM, (bf16*)(wl + WO_FF2), scr, r, lane, nullptr, nullptr, nullptr, nullptr);
        }
        for (int w = gid; w < 2048; w += nthr) ((float*)(ws + WS_LBV))[w] = w < 1024 ? 0.f : sigm(a.lb[w] - a.lb[w - 1024]);
        float* ROPE = (float*)(ws + WS_ROPE);
        for (int w = gid; w < SEQ * 8; w += nthr) {
            const int pos = w >> 3, i = w & 7;
            const float invf = i == 0 ? 1.0f : i == 1 ? 0.19392274474868576f : i == 2 ? 0.03760603093086393f : i == 3 ? 0.007292664737217109f
                             : i == 4 ? 0.001414213562373095f : i == 5 ? 0.0002742481756762073f : i == 6 ? 5.318295896944988e-05f : 1.031338537721246e-05f;
            const float ang = (float)pos * invf;
            const double rev = (double)ang * 0.15915494309189535;
            const float fr_ = (float)(rev - __builtin_rint(rev));
            ROPE[pos * 16 + i] = __builtin_amdgcn_cosf(fr_); ROPE[pos * 16 + 8 + i] = __builtin_amdgcn_sinf(fr_);
        }
    }
    grid.sync();

#define OG_PTR() ({ float* p_ = a.out; int gg_ = g; asm volatile("" : "+s"(p_), "+s"(gg_)); (float*)((unsigned long long)p_ + (unsigned long long)(unsigned)gg_ * ((unsigned long long)MG * DM * 4ull)); })
#define SEL_PTR(c, pa, pb) ({ unsigned long long a_ = (unsigned long long)(pa), b_ = (unsigned long long)(pb); int c_ = (c); asm volatile("" : "+s"(a_), "+s"(b_), "+s"(c_)); \
        const unsigned long long r_ = b_ + ((a_ - b_) & (0ull - (unsigned long long)(c_ != 0))); \
        (const float*)(((unsigned long long)(unsigned)__builtin_amdgcn_readfirstlane((unsigned)(r_ >> 32)) << 32) | (unsigned)__builtin_amdgcn_readfirstlane((unsigned)r_)); })
#define WL(off) WSQ(const bf16*, WS_W + (size_t)l * WS_WL + (off))
#pragma unroll 1
    for (int g = 0; g < NGROUPS; ++g) {
        {
            bf16* XB = WSQ(bf16*, WS_XB); const float* xp = a.xin[0]; const float* xv = a.xin[1] - (size_t)XSPLIT * DM;
            int tidc = threadIdx.x; asm volatile("" : "+v"(tidc)); const int gid = cu * NTHR + tidc, nthr = G * NTHR;
            for (int w = gid; w < MG * DM / 8; w += nthr) {
                const size_t e = (size_t)g * MG * DM + (size_t)w * 8; const float* src = (e < (size_t)XSPLIT * DM ? xp : xv) + e;
                const f32x4 v0 = *(const f32x4*)src, v1 = *(const f32x4*)(src + 4);
                *(u32x4*)(XB + (size_t)w * 8) = pack8(v0, v1);
            }
        }
        xcd_barrier(bar);
#pragma unroll 1
        for (int l = 0; l < 2; ++l) {
            { pg8::Gemm gm{WSQ(const bf16*, WS_XB), WL(0), MG, HP, DM}; pg8::StaticOrder S; S.init(MG, HP, G, cu);
              EpiH E{WSQ(bf16*, WS_H), WSQ(const float*, WS_ROPE), WSQ(const float*, WS_ST2), WSQ(const float*, WS_CSIN), WSQ(const float*, WS_BWIN), l};
              pg8::gemm_phase<EpiH, pg8::StaticOrder, true, true>(lds, gm, S, E); }
            xcd_barrier(bar);
            hgrn_pass1(lds, WSQ(const bf16*, WS_H), WSQ(bf16*, WS_SB), WSQ(float*, WS_DEC), WSQ(const float*, WS_LBV), l, G, cu);
            xcd_barrier(bar);
            { const int GP = G >= 8 ? G / 4 : 0, isp = (cu & 3) == 3;
              const int pG = GP ? GP : G, pcu = GP ? (isp ? (cu >> 2) : (1 << 20)) : cu;
              const int aG = GP ? G - GP : G, acu = GP ? (isp ? (1 << 20) : cu - (cu >> 2)) : cu;
              hgrn_prefix(WSQ(bf16*, WS_SB), WSQ(const float*, WS_DEC), pG, pcu);
              attn_phase(lds, WSQ(const bf16*, WS_H), WSQ(bf16*, WS_OATT), a.sink + l * 8, aG, acu); }
            { float* ST1 = WSQ(float*, WS_ST1); float* ST2 = WSQ(float*, WS_ST2);
              int tz = threadIdx.x; asm volatile("" : "+v"(tz)); for (int w = cu * NTHR + tz; w < 2 * MG; w += G * NTHR) { ST1[w] = 0.f; if (l == 0) { ST2[w] = 0.f; ST2[2 * MG + w] = 0.f; } } }
            xcd_barrier(bar);
            { pg8::Gemm gm{WSQ(const bf16*, WS_OATT), WL(WO_PA), MG, DM, 512}; pg8::StaticOrder S; S.init(MG, DM, G, cu);
              EpiMix<false> E{WSQ(const bf16*, WS_H) + C_GA, WSQ(bf16*, WS_MIX)};
              pg8::gemm_phase<EpiMix<false>, pg8::StaticOrder, true, true>(lds, gm, S, E); }
            hgrn_pass3(lds, WSQ(const bf16*, WS_H), WSQ(const bf16*, WS_SB), WSQ(bf16*, WS_OHG), WSQ(const float*, WS_LBV), a.ng + l * 64, l, G, cu);
            xcd_barrier(bar);
            { pg8::Gemm gm{WSQ(const bf16*, WS_OHG), WL(WO_PH), MG, DM, 512}; pg8::StaticOrder S; S.init(MG, DM, G, cu);
              EpiMix<true> E{WSQ(const bf16*, WS_H) + C_GB, WSQ(bf16*, WS_MIX)};
              pg8::gemm_phase<EpiMix<true>, pg8::StaticOrder, true, true>(lds, gm, S, E); }
            xcd_barrier(bar);
            { pg8::Gemm gm{WSQ(const bf16*, WS_MIX), WL(WO_OUT), MG, DM, DM}; pg8::StaticOrder S; S.init(MG, DM, G, cu);
              EpiRes E{WSQ(bf16*, WS_XB), l, WSQ(const float*, WS_ST2), a.ln2g, a.ln2b, WSQ(float*, WS_ST1)};
              pg8::gemm_phase<EpiRes, pg8::StaticOrder, true, true>(lds, gm, S, E); }
            xcd_barrier(bar);
            { pg8::Gemm gm{WSQ(const bf16*, WS_XB), WL(WO_FF1), MG, DFF, DM}; pg8::StaticOrder S; S.init(MG, DFF, G, cu);
              EpiFF1 E{WSQ(bf16*, WS_H), WSQ(const float*, WS_ST1), WSQ(const float*, WS_CS1) + l * DFF, WSQ(const float*, WS_BW1) + l * DFF};
              pg8::gemm_phase<EpiFF1, pg8::StaticOrder, true, true>(lds, gm, S, E); }
            xcd_barrier(bar);
            { pg8::Gemm gm{WSQ(const bf16*, WS_H), WL(WO_FF2), MG, DM, DFF}; pg8::StaticOrder S; S.init(MG, DM, G, cu);
              EpiRes E{WSQ(bf16*, WS_XB), 1, WSQ(const float*, WS_ST1), a.ln1g + l * DM, a.ln1b + l * DM, WSQ(float*, WS_ST2) + (size_t)l * 2 * MG};
              pg8::gemm_phase<EpiRes, pg8::StaticOrder, true, true>(lds, gm, S, E); }
            xcd_barrier(bar);
            if (l == 1) { ln_final(WSQ(const bf16*, WS_XB), WSQ(const float*, WS_ST2) + (size_t)2 * MG, OG_PTR(), a.ln2g + DM, a.ln2b + DM, G, cu); xcd_barrier(bar); }
        }
    }
}

extern "C" void kernel_launch(void* const* d_in, const int* in_sizes, int n_in, void* d_out, int out_size, void* d_ws, size_t ws_size, hipStream_t stream) {
    static int grid = 0;
    if (grid == 0) {
        if (n_in != 15 || ws_size < WS_END) { fprintf(stderr, "kernel_launch: unexpected n_in %d / ws_size %zu\n", n_in, ws_size); grid = -1; return; }
        int dev = 0, cus = 0, per_cu = 0;
        (void)hipGetDevice(&dev);
        (void)hipDeviceGetAttribute(&cus, hipDeviceAttributeMultiprocessorCount, dev);
        if (hipFuncSetAttribute((const void*)fwd_kernel, hipFuncAttributeMaxDynamicSharedMemorySize, LDS_BYTES) != hipSuccess) { fprintf(stderr, "kernel_launch: hipFuncSetAttribute failed\n"); grid = -1; return; }
        if (hipOccupancyMaxActiveBlocksPerMultiprocessor(&per_cu, (const void*)fwd_kernel, NTHR, LDS_BYTES) != hipSuccess || per_cu < 1) per_cu = 1;
        (void)hipGetLastError();
        grid = cus * per_cu;
    }
    if (grid < 0) return;
    Args a{};
    a.xin[0] = (const float*)d_in[0]; a.xin[1] = (const float*)d_in[1];
    a.w_in = (const float*)d_in[2]; a.sink = (const float*)d_in[3]; a.lb = (const float*)d_in[4]; a.ng = (const float*)d_in[5];
    a.wpa = (const float*)d_in[6]; a.wph = (const float*)d_in[7]; a.wout = (const float*)d_in[8];
    a.ln1g = (const float*)d_in[9]; a.ln1b = (const float*)d_in[10]; a.ff1 = (const float*)d_in[11]; a.ff2 = (const float*)d_in[12];
    a.ln2g = (const float*)d_in[13]; a.ln2b = (const float*)d_in[14];
    a.out = (float*)d_out; a.ws = (unsigned char*)d_ws;
    if (hipMemsetAsync(d_ws, 0, 1 << 20, stream) != hipSuccess) { fprintf(stderr, "kernel_launch: memset failed\n"); return; }
    void* args[] = {&a};
    hipError_t e = hipLaunchCooperativeKernel((const void*)fwd_kernel, dim3(grid), dim3(NTHR), args, LDS_BYTES, stream);
    if (e != hipSuccess) fprintf(stderr, "cooperative launch failed: %s (grid %d)\n", hipGetErrorString(e), grid);
}
```

```cpp
#include <hip/hip_runtime.h>
#include <hip/hip_cooperative_groups.h>
#include <cstdio>
#include <cstdint>
namespace cg = cooperative_groups;
namespace pg8 {
#define PG8_LAS __attribute__((address_space(3)))
typedef unsigned short bf16_t;
typedef short bf16x8 __attribute__((ext_vector_type(8)));
typedef float f32x4 __attribute__((ext_vector_type(4)));
typedef unsigned u32x4 __attribute__((ext_vector_type(4)));
constexpr int BM = 256, BK = 64, HALF = 128, HTB = HALF * BK * 2  , STAGE_BYTES = 8 * HTB, NXCD = 8, WGM = 8;

__host__ __device__ __forceinline__ int lds_byte(int r, int c) { const int st = (r >> 4) * 2 + (c >> 5), rr = r & 15, cc = c & 31, ob = rr * 64 + cc * 2; return st * 1024 + (ob ^ (((ob >> 9) & 1) << 5)); }
__host__ __device__ __forceinline__ void stage_rc(int b, int& R, int& C) { const int st = b / 1024, sb = b % 1024, swz = sb ^ (((sb >> 9) & 1) << 5); R = (st >> 1) * 16 + swz / 64; C = (st & 1) * 32 + (swz % 64) / 2; }
__host__ __device__ __forceinline__ int perm32(int rho) { const int n = rho >> 4, i = rho & 15; return 8 * (i >> 2) + 4 * n + (i & 3); }

struct Unit { int pm, pn; };
struct Gemm { const bf16_t* A; const bf16_t* Bt; int M, N, K; };

struct StaticOrder {
    int nM, nN, nwg, G, c;
    __host__ __device__ void init(int M, int N, int G_, int c_) { nM = M / BM; nN = N / BM; nwg = nM * nN; G = G_; c = c_; }
    __host__ __device__ bool next(int i, Unit& u) const {
        const long L = (long)i * G + c; if (L >= nwg) return false;
        int wgid = (int)L; { const int q = nwg / NXCD, r = nwg % NXCD, xcd = wgid % NXCD, off = wgid / NXCD; wgid = (xcd < r ? xcd * (q + 1) : r * (q + 1) + (xcd - r) * q) + off; }
        const int nig = WGM * nN, gid = wgid / nig, fm = gid * WGM, gsz = (nM - fm) < WGM ? (nM - fm) : WGM;
        u.pm = fm + ((wgid % nig) % gsz); u.pn = (wgid % nig) / gsz; return true;
    }
    __device__ __forceinline__ void a_ready(const Unit&) const {}
    __device__ __forceinline__ void done(const Unit&) const {}
};

__device__ __forceinline__ unsigned cvt_pk_bf16(float lo, float hi) { unsigned r; asm volatile("v_cvt_pk_bf16_f32 %0, %1, %2" : "=v"(r) : "v"(lo), "v"(hi)); return r; }
typedef float f32x2 __attribute__((ext_vector_type(2)));
template <class Epi, class Sched, bool ALIGN_EPI = false, bool SP2 = false>
__device__ __forceinline__ void gemm_phase(PG8_LAS unsigned char* lds, const Gemm g, const Sched& S, const Epi& E) {
    int tid_ = threadIdx.x; asm volatile("" : "+v"(tid_));
    const int tid = tid_, wid = __builtin_amdgcn_readfirstlane(tid >> 6), lane = tid & 63, wr = wid >> 2, wc = wid & 3, fr = lane & 15, fq = lane >> 4;
    const int K = g.K, nt = K / BK;
    unsigned voffA[2], voffB[2];
#pragma unroll
    for (int i = 0; i < 2; ++i) { int R, C; stage_rc(tid * 16 + i * 8192, R, C); const int Rb = Epi::PERM ? ((R & ~31) + perm32(R & 31)) : R;
        voffA[i] = (unsigned)(R * K + C) * 2u; voffB[i] = (unsigned)(Rb * K + C) * 2u; }
    const size_t kstep = (size_t)(BK * 2);
    const size_t hstep = (size_t)HALF * K * 2;
    const size_t tstep = 2 * hstep;
    const unsigned ldsw = (unsigned)wid * 1024u;
    const int aoff = lds_byte(wr * 64 + fr, fq * 8), boff = lds_byte(wc * 32 + fr, fq * 8);
#define PG8_SA(b, h) (((b) * 2 + (h)) * HTB)
#define PG8_SB(b, h) ((4 + (b) * 2 + (h)) * HTB)
#define PG8_STAGE(bufoff, gbase, voff) do { _Pragma("unroll") for (int _i = 0; _i < 2; ++_i) \
        __builtin_amdgcn_global_load_lds((const unsigned*)((const char*)(gbase) + (voff)[_i]), (PG8_LAS unsigned*)(lds + (bufoff) + ldsw + _i * 8192), 16, 0, 0); } while (0)
#define PG8_LDA(dst, b, h) do { _Pragma("unroll") for (int m = 0; m < 4; ++m) _Pragma("unroll") for (int k = 0; k < 2; ++k) dst[m][k] = *(const PG8_LAS bf16x8*)(lds + PG8_SA(b, h) + aoff + m * 2048 + k * 1024); } while (0)
#define PG8_LDB(dst, b, h) do { _Pragma("unroll") for (int n = 0; n < 2; ++n) _Pragma("unroll") for (int k = 0; k < 2; ++k) dst[n][k] = *(const PG8_LAS bf16x8*)(lds + PG8_SB(b, h) + boff + n * 2048 + k * 1024); } while (0)
#define PG8_MMA(ai, bj, At, Bt) do { __builtin_amdgcn_s_setprio(1); _Pragma("unroll") for (int m = 0; m < 4; ++m) _Pragma("unroll") for (int n = 0; n < 2; ++n) _Pragma("unroll") for (int k = 0; k < 2; ++k) \
        acc[ai][bj][m][n] = __builtin_amdgcn_mfma_f32_16x16x32_bf16(Bt[n][k], At[m][k], acc[ai][bj][m][n], 0, 0, 0); __builtin_amdgcn_s_setprio(0); } while (0)
#define PG8_WAIT_V(n) asm volatile("s_waitcnt vmcnt(" #n ")" ::: "memory")
#define PG8_WAIT_L(n) asm volatile("s_waitcnt lgkmcnt(" #n ")" ::: "memory")
#define PG8_BAR __builtin_amdgcn_s_barrier()
#define PG8_SCHED __builtin_amdgcn_sched_barrier(0)
    Unit cur, nxt; int ui = 0;
    if (!S.next(0, cur)) return;
    f32x4 acc[2][2][4][2];
#pragma unroll
    for (int a = 0; a < 2; ++a)
#pragma unroll
        for (int b = 0; b < 2; ++b)
#pragma unroll
            for (int m = 0; m < 4; ++m)
#pragma unroll
                for (int n = 0; n < 2; ++n) acc[a][b][m][n] = (f32x4){0.f, 0.f, 0.f, 0.f};
    bf16x8 At[4][2], B0[2][2], B1[2][2];
    const char* cA = (const char*)g.A + (size_t)cur.pm * tstep; const char* cB = (const char*)g.Bt + (size_t)cur.pn * tstep;
    S.a_ready(cur);
    if constexpr (SP2) {
        PG8_STAGE(PG8_SB(0, 0), cB, voffB); PG8_STAGE(PG8_SB(0, 1), cB + hstep, voffB); PG8_STAGE(PG8_SA(0, 0), cA, voffA); PG8_STAGE(PG8_SA(0, 1), cA + hstep, voffA);
        if (wr == 1) PG8_BAR;
        PG8_WAIT_V(2); PG8_BAR;
        PG8_STAGE(PG8_SB(1, 0), cB + kstep, voffB); PG8_STAGE(PG8_SA(1, 0), cA + kstep, voffA); PG8_STAGE(PG8_SB(1, 1), cB + hstep + kstep, voffB);
        PG8_WAIT_V(6); PG8_BAR;
    } else {
        PG8_STAGE(PG8_SB(0, 0), cB, voffB); PG8_STAGE(PG8_SA(0, 0), cA, voffA); PG8_STAGE(PG8_SB(0, 1), cB + hstep, voffB); PG8_STAGE(PG8_SA(0, 1), cA + hstep, voffA);
        if (wr == 1) PG8_BAR;
        PG8_WAIT_V(4); PG8_BAR;
        PG8_STAGE(PG8_SB(1, 0), cB + kstep, voffB); PG8_STAGE(PG8_SA(1, 0), cA + kstep, voffA); PG8_STAGE(PG8_SB(1, 1), cB + hstep + kstep, voffB);
        PG8_WAIT_V(6); PG8_BAR;
    }
    for (;;) {
        const bool has_next = S.next(ui + 1, nxt);
        const char* nA = has_next ? (const char*)g.A + (size_t)nxt.pm * tstep : cA; const char* nB = has_next ? (const char*)g.Bt + (size_t)nxt.pn * tstep : cB;
        for (int t = 0; t < nt; t += 2) {
            const bool last = (t == nt - 2);
            const char* a1 = cA + (size_t)(t + 1) * kstep;
            const char* a2 = last ? nA : cA + (size_t)(t + 2) * kstep; const char* b2 = last ? nB : cB + (size_t)(t + 2) * kstep;
            const char* a3 = a2 + kstep; const char* b3 = b2 + kstep;
            if (last && has_next) S.a_ready(nxt);
            if constexpr (SP2) {
            PG8_LDB(B0, 0, 0); PG8_LDB(B1, 0, 1); PG8_SCHED; PG8_LDA(At, 0, 0); PG8_STAGE(PG8_SA(1, 1), a1 + hstep, voffA);
            PG8_WAIT_V(8); PG8_WAIT_L(0); PG8_BAR; PG8_MMA(0, 0, At, B0); PG8_MMA(0, 1, At, B1); PG8_BAR; PG8_SCHED;
            PG8_LDA(At, 0, 1); PG8_STAGE(PG8_SB(0, 0), b2, voffB); PG8_STAGE(PG8_SB(0, 1), b2 + hstep, voffB); PG8_STAGE(PG8_SA(0, 0), a2, voffA);
            PG8_WAIT_V(8); PG8_WAIT_L(0); PG8_BAR; PG8_MMA(1, 0, At, B0); PG8_MMA(1, 1, At, B1); PG8_BAR; PG8_SCHED;
            PG8_LDB(B0, 1, 0); PG8_LDB(B1, 1, 1); PG8_SCHED; PG8_LDA(At, 1, 0); PG8_STAGE(PG8_SA(0, 1), a2 + hstep, voffA);
            PG8_WAIT_V(8); PG8_WAIT_L(0); PG8_BAR; PG8_MMA(0, 0, At, B0); PG8_MMA(0, 1, At, B1); PG8_BAR; PG8_SCHED;
            PG8_LDA(At, 1, 1); PG8_STAGE(PG8_SB(1, 0), b3, voffB); PG8_STAGE(PG8_SB(1, 1), b3 + hstep, voffB); PG8_STAGE(PG8_SA(1, 0), a3, voffA);
            PG8_WAIT_V(8); PG8_WAIT_L(0); PG8_BAR; PG8_MMA(1, 0, At, B0); PG8_MMA(1, 1, At, B1); PG8_BAR; PG8_SCHED;
            } else {
            PG8_LDB(B0, 0, 0); PG8_SCHED; PG8_LDA(At, 0, 0); PG8_STAGE(PG8_SA(1, 1), a1 + hstep, voffA);
            PG8_WAIT_L(8); PG8_BAR; PG8_WAIT_L(0); PG8_MMA(0, 0, At, B0); PG8_BAR; PG8_SCHED;
            PG8_LDB(B1, 0, 1); PG8_STAGE(PG8_SB(0, 0), b2, voffB);
            PG8_BAR; PG8_WAIT_L(0); PG8_MMA(0, 1, At, B1); PG8_BAR;
            PG8_LDA(At, 0, 1); PG8_STAGE(PG8_SA(0, 0), a2, voffA);
            PG8_BAR; PG8_WAIT_L(0); PG8_MMA(1, 0, At, B0); PG8_BAR; PG8_SCHED;
            PG8_STAGE(PG8_SB(0, 1), b2 + hstep, voffB);
            PG8_WAIT_V(6); PG8_BAR; PG8_MMA(1, 1, At, B1); PG8_BAR;
            PG8_LDB(B0, 1, 0); PG8_SCHED; PG8_LDA(At, 1, 0); PG8_STAGE(PG8_SA(0, 1), a2 + hstep, voffA);
            PG8_WAIT_L(8); PG8_BAR; PG8_WAIT_L(0); PG8_MMA(0, 0, At, B0); PG8_BAR; PG8_SCHED;
            PG8_LDB(B1, 1, 1); PG8_STAGE(PG8_SB(1, 0), b3, voffB);
            PG8_BAR; PG8_WAIT_L(0); PG8_MMA(0, 1, At, B1); PG8_BAR;
            PG8_LDA(At, 1, 1); PG8_STAGE(PG8_SA(1, 0), a3, voffA);
            PG8_BAR; PG8_WAIT_L(0); PG8_MMA(1, 0, At, B0); PG8_BAR; PG8_SCHED;
            PG8_STAGE(PG8_SB(1, 1), b3 + hstep, voffB);
            PG8_WAIT_V(6); PG8_BAR; PG8_MMA(1, 1, At, B1); PG8_BAR;
            }
        }
        if constexpr (ALIGN_EPI) { if (wr == 0) PG8_BAR; }
        if constexpr (!Epi::AFTER_DRAIN) { E(acc, cur, wr, wc, fr, fq); S.done(cur); }
        if (!has_next) break;
#pragma unroll
        for (int a = 0; a < 2; ++a)
#pragma unroll
            for (int b = 0; b < 2; ++b)
#pragma unroll
                for (int m = 0; m < 4; ++m)
#pragma unroll
                    for (int n = 0; n < 2; ++n) acc[a][b][m][n] = (f32x4){0.f, 0.f, 0.f, 0.f};
        cur = nxt; cA = nA; cB = nB; ++ui;
        if constexpr (ALIGN_EPI) { if (wr == 1) PG8_BAR; }
    }
    PG8_WAIT_V(0);
    if constexpr (!ALIGN_EPI) { if (wr == 0) PG8_BAR; }
    PG8_BAR;
    if constexpr (Epi::AFTER_DRAIN) { E.fused(acc, cur, wr, wc, fr, fq, lds, wid, lane); S.done(cur); }
#undef PG8_SA
#undef PG8_SB
#undef PG8_STAGE
#undef PG8_LDA
#undef PG8_LDB
#undef PG8_MMA
#undef PG8_WAIT_V
#undef PG8_WAIT_L
#undef PG8_BAR
#undef PG8_SCHED
}
}

constexpr int NTHR = 512;
constexpr int DM = 1024, SEQ = 4096, HP = 5376, DFF = 4096;
constexpr int GSEQ = 12, MG = GSEQ * SEQ, NGROUPS = 2;
constexpr int XSPLIT = 8 * SEQ;
constexpr int C_AK = 512, C_AV = 640, C_HQ = 768, C_HFF = 1280, C_HI = 2304, C_HG = 2816, C_GA = 3328, C_GB = 4352;
constexpr float ALPHA = 1.4142135623730951f, LN_EPS = 1e-5f, RMS_EPS = 1e-6f;
constexpr int LDS_BYTES = 147456;

#define LAS __attribute__((address_space(3)))
typedef unsigned short bf16;
typedef unsigned u32x4 __attribute__((ext_vector_type(4)));
typedef unsigned u32x2 __attribute__((ext_vector_type(2)));
typedef float f32x4 __attribute__((ext_vector_type(4)));
typedef short bf16x8 __attribute__((ext_vector_type(8)));

constexpr size_t MiB = 1u << 20;
constexpr size_t WS_LBV = 32768;
constexpr size_t WS_CS1 = 65536, WS_BW1 = 98304, WS_CSIN = 131072, WS_BWIN = 163840;
constexpr size_t WS_ROPE = 1 * MiB;
constexpr size_t WS_W = 2 * MiB, WS_WL = 31 * MiB;
constexpr size_t WO_PA = 10 * MiB + MiB / 2, WO_PH = 11 * MiB + MiB / 2, WO_OUT = 12 * MiB + MiB / 2, WO_FF1 = 14 * MiB + MiB / 2, WO_FF2 = 22 * MiB + MiB / 2;
constexpr size_t WS_XB = 64 * MiB, WS_H = 160 * MiB, WS_OATT = 664 * MiB, WS_OHG = 712 * MiB, WS_MIX = 760 * MiB, WS_SB = 856 * MiB, WS_DEC = 952 * MiB;
constexpr size_t WS_ST1 = 955 * MiB, WS_ST2 = WS_ST1 + 512 * 1024, WS_END = 958 * MiB;
static_assert((size_t)MG * HP * 2 <= WS_OATT - WS_H && (size_t)MG * DM * 2 <= WS_H - WS_XB && (size_t)MG * 512 * 2 <= WS_OHG - WS_OATT && (size_t)MG * DM * 2 <= WS_SB - WS_MIX && (size_t)GSEQ * 16 * 64 * 8192 <= WS_DEC - WS_SB && (size_t)GSEQ * 16 * 64 * 256 <= WS_ST1 - WS_DEC && (size_t)MG * 8 <= 512 * 1024, "d_ws map");

__device__ __forceinline__ float bf2f(unsigned short u) { return __uint_as_float((unsigned)u << 16); }
__device__ __forceinline__ float bflo(unsigned w) { return __uint_as_float(w << 16); }
__device__ __forceinline__ float bfhi(unsigned w) { return __uint_as_float(w & 0xffff0000u); }
__device__ __forceinline__ unsigned f2bf(float f) { unsigned u = __builtin_bit_cast(unsigned, f); return (u + 0x7fffu + ((u >> 16) & 1u)) >> 16; }
__device__ __forceinline__ float sigm(float x) { return __builtin_amdgcn_rcpf(1.f + __builtin_amdgcn_exp2f(x * -1.4426950408889634f)); }
__device__ __forceinline__ u32x4 pack8(f32x4 a, f32x4 b) { u32x4 w; w.x = pg8::cvt_pk_bf16(a[0], a[1]); w.y = pg8::cvt_pk_bf16(a[2], a[3]); w.z = pg8::cvt_pk_bf16(b[0], b[1]); w.w = pg8::cvt_pk_bf16(b[2], b[3]); return w; }
__device__ __forceinline__ float wave_sum(float v) {
#pragma unroll
    for (int o = 1; o < 64; o <<= 1) v += __shfl_xor(v, o);
    return v;
}

typedef float f32x2v __attribute__((ext_vector_type(2)));
__device__ __forceinline__ void stats_to(const f32x2v st, float& mean, float& rstd) {
    float inv = 1.f / DM; asm volatile("" : "+s"(inv));
    mean = st.x * inv; rstd = __builtin_amdgcn_rsqf(fmaxf(st.y * inv - mean * mean, 0.f) + LN_EPS);
}
struct EpiH {
    static constexpr bool PERM = true, AFTER_DRAIN = false;
    bf16* H; const float* rope; const float* stats; const float* cs; const float* bw; int ln;
    __device__ __forceinline__ void operator()(const f32x4 (&acc)[2][2][4][2], const pg8::Unit& u, int wr, int wc, int fr, int fq) const {
        const int colt = u.pn * 256, rowb = u.pm * 256 + wr * 64 + fr;
        const int act = (u.pn == 3 || u.pn == 4) ? 1 : (u.pn == 11 || u.pn == 12) ? 2 : (u.pn >= 13) ? 3 : 0;
        float mean[8], rstd[8];
#pragma unroll
        for (int r = 0; r < 8; ++r) { mean[r] = 0.f; rstd[r] = 1.f; }
        if (ln) {
            f32x2v st[8];
#pragma unroll
            for (int r = 0; r < 8; ++r) st[r] = *(const f32x2v*)(stats + 2 * (rowb + (r >> 2) * 128 + (r & 3) * 16));
#pragma unroll
            for (int r = 0; r < 8; ++r) stats_to(st[r], mean[r], rstd[r]);
        }
#pragma unroll
        for (int bj = 0; bj < 2; ++bj) {
            const int c0 = colt + bj * 128 + wc * 32 + 8 * fq;
            f32x4 cs0 = (f32x4){0.f, 0.f, 0.f, 0.f}, cs1 = cs0, bw0 = cs0, bw1 = cs0;
            if (ln) { cs0 = *(const f32x4*)(cs + c0); cs1 = *(const f32x4*)(cs + c0 + 4); bw0 = *(const f32x4*)(bw + c0); bw1 = *(const f32x4*)(bw + c0 + 4); }
            const bool ropet = (colt + bj * 128 < 640) && ((wc & 1) == 0);
#pragma unroll
            for (int r = 0; r < 8; ++r) {
                const int ai = r >> 2, m = r & 3, row = rowb + ai * 128 + m * 16;
                f32x4 v0 = acc[ai][bj][m][0], v1 = acc[ai][bj][m][1];
                if (ln) { v0 = (v0 - cs0 * mean[r]) * rstd[r] + bw0; v1 = (v1 - cs1 * mean[r]) * rstd[r] + bw1; }
                if (ropet) {
                    f32x4 p0, p1;
#pragma unroll
                    for (int i = 0; i < 4; ++i) { p0[i] = __shfl_xor(v0[i], 16); p1[i] = __shfl_xor(v1[i], 16); }
                    if (fq < 2) {
                        const float* rp = rope + (size_t)(row & (SEQ - 1)) * 16;
                        const f32x4 c0r = *(const f32x4*)rp, c1r = *(const f32x4*)(rp + 4), s0 = *(const f32x4*)(rp + 8), s1 = *(const f32x4*)(rp + 12);
                        if (fq == 0) { v0 = v0 * c0r - p0 * s0; v1 = v1 * c1r - p1 * s1; }
                        else         { v0 = v0 * c0r + p0 * s0; v1 = v1 * c1r + p1 * s1; }
                    }
                }
                if (u.pn < 2) { v0 = v0 * 0.18033688011112042f; v1 = v1 * 0.18033688011112042f; }
                if (act == 3) {
#pragma unroll
                    for (int i = 0; i < 4; ++i) { v0[i] = sigm(v0[i]); v1[i] = sigm(v1[i]); }
                } else if (act) {
                    const float sc = act == 1 ? 0.125f : 1.f;
#pragma unroll
                    for (int i = 0; i < 4; ++i) { v0[i] = v0[i] * sc * sigm(v0[i]); v1[i] = v1[i] * sc * sigm(v1[i]); }
                }
                *(u32x4*)(H + (size_t)row * HP + c0) = pack8(v0, v1);
            }
            asm volatile("" ::: "memory");
        }
    }
};
template <bool ADD> struct EpiMix {
    static constexpr bool PERM = true, AFTER_DRAIN = false;
    static constexpr int RB = 8;
    const bf16* Hg; bf16* MIX;
    __device__ __forceinline__ void operator()(const f32x4 (&acc)[2][2][4][2], const pg8::Unit& u, int wr, int wc, int fr, int fq) const {
        const int rowb = u.pm * 256 + wr * 64 + fr;
#pragma unroll
        for (int bj = 0; bj < 2; ++bj)
#pragma unroll
            for (int rb = 0; rb < 8; rb += RB) {
                const int c0 = u.pn * 256 + bj * 128 + wc * 32 + 8 * fq;
                u32x4 g[RB], o[RB];
#pragma unroll
                for (int r = 0; r < RB; ++r) { const int row = rowb + ((rb + r) >> 2) * 128 + ((rb + r) & 3) * 16;
                    g[r] = *(const u32x4*)(Hg + (size_t)row * HP + c0);
                    if (ADD) o[r] = *(const u32x4*)(MIX + (size_t)row * DM + c0); }
#pragma unroll
                for (int r = 0; r < RB; ++r) { const int ai = (rb + r) >> 2, m = (rb + r) & 3, row = rowb + ai * 128 + m * 16;
                    f32x4 v0 = acc[ai][bj][m][0], v1 = acc[ai][bj][m][1];
                    v0[0] *= bflo(g[r].x); v0[1] *= bfhi(g[r].x); v0[2] *= bflo(g[r].y); v0[3] *= bfhi(g[r].y);
                    v1[0] *= bflo(g[r].z); v1[1] *= bfhi(g[r].z); v1[2] *= bflo(g[r].w); v1[3] *= bfhi(g[r].w);
                    if (ADD) {
                        v0[0] += bflo(o[r].x); v0[1] += bfhi(o[r].x); v0[2] += bflo(o[r].y); v0[3] += bfhi(o[r].y);
                        v1[0] += bflo(o[r].z); v1[1] += bfhi(o[r].z); v1[2] += bflo(o[r].w); v1[3] += bfhi(o[r].w); }
                    *(u32x4*)(MIX + (size_t)row * DM + c0) = pack8(v0, v1);
                }
                asm volatile("" ::: "memory");
            }
    }
};
struct EpiRes {
    static constexpr bool PERM = true, AFTER_DRAIN = false;
    bf16* xb; int norm; const float* statsIn; const float* gIn; const float* bIn; float* statsOut;
    __device__ __forceinline__ void operator()(const f32x4 (&acc)[2][2][4][2], const pg8::Unit& u, int wr, int wc, int fr, int fq) const {
#pragma unroll
        for (int ai = 0; ai < 2; ++ai) {
            const int rowb = u.pm * 256 + ai * 128 + wr * 64 + fr;
            float s[4], q[4];
#pragma unroll
            for (int m = 0; m < 4; ++m) { s[m] = 0.f; q[m] = 0.f; }
            u32x4 xv[2][4]; f32x2v st[4];
#pragma unroll
            for (int m = 0; m < 4; ++m) {
#pragma unroll
                for (int bj = 0; bj < 2; ++bj) xv[bj][m] = *(const u32x4*)(xb + (size_t)(rowb + m * 16) * DM + u.pn * 256 + bj * 128 + wc * 32 + 8 * fq);
                if (norm) st[m] = *(const f32x2v*)(statsIn + 2 * (rowb + m * 16)); }
#pragma unroll
            for (int bj = 0; bj < 2; ++bj) {
                const int c0 = u.pn * 256 + bj * 128 + wc * 32 + 8 * fq;
                f32x4 g0 = (f32x4){1.f, 1.f, 1.f, 1.f}, g1 = g0, b0 = (f32x4){0.f, 0.f, 0.f, 0.f}, b1 = b0;
                if (norm) { g0 = *(const f32x4*)(gIn + c0); g1 = *(const f32x4*)(gIn + c0 + 4); b0 = *(const f32x4*)(bIn + c0); b1 = *(const f32x4*)(bIn + c0 + 4); }
#pragma unroll
                for (int m = 0; m < 4; ++m) { const u32x4 xw = xv[bj][m];
                    f32x4 x0 = (f32x4){bflo(xw.x), bfhi(xw.x), bflo(xw.y), bfhi(xw.y)}, x1 = (f32x4){bflo(xw.z), bfhi(xw.z), bflo(xw.w), bfhi(xw.w)};
                    if (norm) { float mean, rstd; stats_to(st[m], mean, rstd); x0 = (x0 - mean) * rstd * g0 + b0; x1 = (x1 - mean) * rstd * g1 + b1; }
                    const f32x4 o0 = x0 * ALPHA + acc[ai][bj][m][0], o1 = x1 * ALPHA + acc[ai][bj][m][1];
                    *(u32x4*)(xb + (size_t)(rowb + m * 16) * DM + c0) = pack8(o0, o1);
                    s[m] += ((o0[0] + o0[1]) + (o0[2] + o0[3])) + ((o1[0] + o1[1]) + (o1[2] + o1[3]));
                    q[m] += ((o0[0] * o0[0] + o0[1] * o0[1]) + (o0[2] * o0[2] + o0[3] * o0[3])) + ((o1[0] * o1[0] + o1[1] * o1[1]) + (o1[2] * o1[2] + o1[3] * o1[3]));
                }
            }
#pragma unroll
            for (int m = 0; m < 4; ++m) {
                float ss = s[m], qq = q[m];
                ss += __shfl_xor(ss, 16); ss += __shfl_xor(ss, 32); qq += __shfl_xor(qq, 16); qq += __shfl_xor(qq, 32);
                if (fq == 0) { atomicAdd(statsOut + 2 * (rowb + m * 16), ss); atomicAdd(statsOut + 2 * (rowb + m * 16) + 1, qq); }
            }
            asm volatile("" ::: "memory");
        }
    }
};
struct EpiFF1 {
    static constexpr bool PERM = true, AFTER_DRAIN = false;
    bf16* F; const float* stats; const float* cs; const float* bw;
    __device__ __forceinline__ void operator()(const f32x4 (&acc)[2][2][4][2], const pg8::Unit& u, int wr, int wc, int fr, int fq) const {
        const int rowb = u.pm * 256 + wr * 64 + fr;
        float mean[8], rstd[8];
        {
            f32x2v st[8];
#pragma unroll
            for (int r = 0; r < 8; ++r) st[r] = *(const f32x2v*)(stats + 2 * (rowb + (r >> 2) * 128 + (r & 3) * 16));
#pragma unroll
            for (int r = 0; r < 8; ++r) stats_to(st[r], mean[r], rstd[r]);
        }
#pragma unroll
        for (int bj = 0; bj < 2; ++bj) {
            const int c0 = u.pn * 256 + bj * 128 + wc * 32 + 8 * fq;
            const f32x4 cs0 = *(const f32x4*)(cs + c0), cs1 = *(const f32x4*)(cs + c0 + 4), bw0 = *(const f32x4*)(bw + c0), bw1 = *(const f32x4*)(bw + c0 + 4);
#pragma unroll
            for (int r = 0; r < 8; ++r) { const int ai = r >> 2, m = r & 3, row = rowb + ai * 128 + m * 16;
                f32x4 v0 = (acc[ai][bj][m][0] - cs0 * mean[r]) * rstd[r] + bw0, v1 = (acc[ai][bj][m][1] - cs1 * mean[r]) * rstd[r] + bw1;
#pragma unroll
                for (int i = 0; i < 4; ++i) { const float a = fmaxf(v0[i], 0.f), b = fmaxf(v1[i], 0.f); v0[i] = a * a; v1[i] = b * b; }
                *(u32x4*)(F + (size_t)row * DFF + c0) = pack8(v0, v1);
            }
            asm volatile("" ::: "memory");
        }
    }
};

__device__ __forceinline__ void transpose_item(const float* W, int K, int N, bf16* WT, LAS float* scr, int item, int lane, const float* gk, const float* bk, float* cs, float* bw) {
    const int nblk = N / 32, kb = item / nblk, nb = item % nblk, k0 = 64 * kb, n0 = 32 * nb;
    float csum = 0.f, bsum = 0.f;
#pragma unroll
    for (int i = 0; i < 32; ++i) { const int kk = 2 * i + (lane >> 5); float w = W[(size_t)(k0 + kk) * N + n0 + (lane & 31)];
        if (gk) { const float wg = w * gk[k0 + kk]; bsum += w * bk[k0 + kk]; w = wg; csum += __uint_as_float(f2bf(wg) << 16); }
        scr[kk * 33 + (lane & 31)] = w; }
    if (gk) { csum += __shfl_xor(csum, 32); bsum += __shfl_xor(bsum, 32); if (lane < 32) { atomicAdd(cs + n0 + lane, csum); atomicAdd(bw + n0 + lane, bsum); } }
    asm volatile("s_waitcnt lgkmcnt(0)" ::: "memory");
    const int c = lane & 7;
#pragma unroll
    for (int j = 0; j < 4; ++j) { const int n = (lane >> 3) + 8 * j; const LAS float* s = scr + (8 * c) * 33 + n;
        u32x4 o; o.x = pg8::cvt_pk_bf16(s[0 * 33], s[1 * 33]); o.y = pg8::cvt_pk_bf16(s[2 * 33], s[3 * 33]); o.z = pg8::cvt_pk_bf16(s[4 * 33], s[5 * 33]); o.w = pg8::cvt_pk_bf16(s[6 * 33], s[7 * 33]);
        *(u32x4*)(WT + (size_t)(n0 + n) * K + k0 + 8 * c) = o; }
    asm volatile("s_waitcnt lgkmcnt(0)" ::: "memory");
}

__device__ __forceinline__ void ln_final(const bf16* XB, const float* stats, float* out, const float* g, const float* b, int G, int cu) {
    int tid = threadIdx.x; asm volatile("" : "+v"(tid)); const int gid = cu * NTHR + tid, nthr = G * NTHR;
    for (int w = gid; w < MG * DM / 8; w += nthr) {
        const int row = w >> 7, c0 = (w & 127) * 8;
        const u32x4 xv = *(const u32x4*)(XB + (size_t)w * 8);
        float mean, rstd; stats_to(*(const f32x2v*)(stats + 2 * row), mean, rstd);
        const f32x4 g0 = *(const f32x4*)(g + c0), g1 = *(const f32x4*)(g + c0 + 4), b0 = *(const f32x4*)(b + c0), b1 = *(const f32x4*)(b + c0 + 4);
        const f32x4 x0 = (f32x4){bflo(xv.x), bfhi(xv.x), bflo(xv.y), bfhi(xv.y)}, x1 = (f32x4){bflo(xv.z), bfhi(xv.z), bflo(xv.w), bfhi(xv.w)};
        *(f32x4*)(out + (size_t)w * 8) = (x0 - mean) * rstd * g0 + b0;
        *(f32x4*)(out + (size_t)w * 8 + 4) = (x1 - mean) * rstd * g1 + b1;
    }
}

constexpr int AT_KP = 144  , AT_VP = 408  , AT_VOFF = 400 * AT_KP;
__device__ __forceinline__ void attn_phase(LAS unsigned char* lds, const bf16* H, bf16* OATT, const float* sink, int G, int cu) {
    int tid = threadIdx.x; asm volatile("" : "+v"(tid)); const int lane = tid & 63, wave = __builtin_amdgcn_readfirstlane(tid >> 6);
    const int fr = lane & 15, fq = lane >> 4;
    LAS unsigned char* ldsK = lds; LAS unsigned short* ldsV = (LAS unsigned short*)(lds + AT_VOFF);
    for (int unit = cu; unit < GSEQ * 32 * 2; unit += G) {
        const int seq = unit >> 6, nb = (unit >> 1) & 31, kvh = unit & 1;
        const int rowbase = seq * SEQ, kpos0 = nb * 128 - 128;
        const int r0 = 16 * wave;
        const size_t qrow = (size_t)rowbase + nb * 128 + r0 + fr;
        bf16x8 qall[4][2];
#pragma unroll
        for (int g = 0; g < 4; ++g) { qall[g][0] = *(const bf16x8*)(H + qrow * HP + (kvh * 4 + g) * 64 + fq * 8); qall[g][1] = *(const bf16x8*)(H + qrow * HP + (kvh * 4 + g) * 64 + 32 + fq * 8); }
        u32x4 kst[7], vst[7];
#pragma unroll
        for (int i = 0; i < 7; ++i) {
            const int c = tid + i * NTHR, ch = c / 400, r = c - ch * 400, pos = kpos0 + r;
            const bool ok = (c < 3200) && (r < 384) && (pos >= 0) && (pos < SEQ);
            kst[i] = (u32x4){0u, 0u, 0u, 0u}; vst[i] = (u32x4){0u, 0u, 0u, 0u};
            if (ok) { const bf16* src = H + (size_t)(rowbase + pos) * HP + kvh * 64 + ch * 8; kst[i] = *(const u32x4*)(src + C_AK); vst[i] = *(const u32x4*)(src + C_AV); }
        }
        __syncthreads();
#pragma unroll
        for (int i = 0; i < 7; ++i) {
            const int c = tid + i * NTHR, ch = c / 400, r = c - ch * 400;
            if (c < 3200) {
                *(LAS u32x4*)(ldsK + r * AT_KP + ch * 16) = kst[i];
                LAS unsigned short* vp = ldsV + (ch * 8) * AT_VP + r; const u32x4 vv = vst[i];
                vp[0 * AT_VP] = (unsigned short)(vv.x & 0xffffu); vp[1 * AT_VP] = (unsigned short)(vv.x >> 16);
                vp[2 * AT_VP] = (unsigned short)(vv.y & 0xffffu); vp[3 * AT_VP] = (unsigned short)(vv.y >> 16);
                vp[4 * AT_VP] = (unsigned short)(vv.z & 0xffffu); vp[5 * AT_VP] = (unsigned short)(vv.z >> 16);
                vp[6 * AT_VP] = (unsigned short)(vv.w & 0xffffu); vp[7 * AT_VP] = (unsigned short)(vv.w >> 16);
            }
        }
        __syncthreads();
#pragma unroll
        for (int g = 0; g < 4; ++g) {
            const int head = kvh * 4 + g;
            bf16x8 qf[2]; qf[0] = qall[g][0]; qf[1] = qall[g][1];
            f32x4 s[18];
            s[17] = (f32x4){0.f, 0.f, 0.f, 0.f};
#pragma unroll
            for (int kt = 0; kt < 17; ++kt) {
                s[kt] = (f32x4){0.f, 0.f, 0.f, 0.f};
#pragma unroll
                for (int kk = 0; kk < 2; ++kk) {
                    const bf16x8 a = *(const LAS bf16x8*)(ldsK + (r0 + kt * 16 + fr) * AT_KP + kk * 64 + fq * 16);
                    s[kt] = __builtin_amdgcn_mfma_f32_16x16x32_bf16(a, qf[kk], s[kt], 0, 0, 0);
                }
            }
            const float sk = sink[head] * 1.4426950408889634f;
            float mx = sk;
            if (nb == 0 || nb == 31) {
#pragma unroll
                for (int kt = 0; kt < 17; ++kt)
#pragma unroll
                    for (int i = 0; i < 4; ++i) {
                        const int kl = r0 + kt * 16 + 4 * fq + i, rel = kt * 16 + 4 * fq + i - 128 - fr, ap = kpos0 + kl;
                        const bool ok = (rel >= -128) && (rel <= 128) && (ap >= 0) && (ap < SEQ);
                        const float v = ok ? s[kt][i] : -INFINITY;
                        s[kt][i] = v; mx = fmaxf(mx, v);
                    }
            } else {
#pragma unroll
                for (int kt = 0; kt < 17; ++kt)
#pragma unroll
                    for (int i = 0; i < 4; ++i) {
                        float v = s[kt][i];
                        if (kt == 0 || kt >= 16) { const int rel = kt * 16 + 4 * fq + i - 128 - fr; v = ((rel >= -128) && (rel <= 128)) ? v : -INFINITY; }
                        s[kt][i] = v; mx = fmaxf(mx, v);
                    }
            }
            mx = fmaxf(mx, __shfl_xor(mx, 16)); mx = fmaxf(mx, __shfl_xor(mx, 32));
            float sum = 0.f;
#pragma unroll
            for (int kt = 0; kt < 17; ++kt)
#pragma unroll
                for (int i = 0; i < 4; ++i) { const float p = __builtin_amdgcn_exp2f(s[kt][i] - mx); s[kt][i] = p; sum += p; }
            sum += __shfl_xor(sum, 16); sum += __shfl_xor(sum, 32);
            const float inv = 1.f / (sum + __builtin_amdgcn_exp2f(sk - mx));
            f32x4 o[4];
#pragma unroll
            for (int dt = 0; dt < 4; ++dt) o[dt] = (f32x4){0.f, 0.f, 0.f, 0.f};
#pragma unroll
            for (int kb = 0; kb < 9; ++kb) {
                const bf16x8 pb = __builtin_bit_cast(bf16x8, pack8(s[2 * kb], s[2 * kb + 1]));
#pragma unroll
                for (int dt = 0; dt < 4; ++dt) {
                    const LAS unsigned short* vp = ldsV + (dt * 16 + fr) * AT_VP + r0 + kb * 32 + 4 * fq;
                    const u32x2 lo = *(const LAS u32x2*)vp, hi = *(const LAS u32x2*)(vp + 16);
                    const bf16x8 a = __builtin_bit_cast(bf16x8, (u32x4){lo.x, lo.y, hi.x, hi.y});
                    o[dt] = __builtin_amdgcn_mfma_f32_16x16x32_bf16(a, pb, o[dt], 0, 0, 0);
                }
            }
#pragma unroll
            for (int dt = 0; dt < 4; ++dt) {
                u32x2 w; w.x = pg8::cvt_pk_bf16(o[dt][0] * inv, o[dt][1] * inv); w.y = pg8::cvt_pk_bf16(o[dt][2] * inv, o[dt][3] * inv);
                *(u32x2*)(OATT + qrow * 512 + head * 64 + dt * 16 + 4 * fq) = w;
            }
        }
    }
    __syncthreads();
}

constexpr int HG_P = 72;
constexpr int HL_T0 = 2048, HL_TSZ = 64 * HG_P * 2  ;
constexpr int HG_ITEMS = GSEQ * 64 * 8;
struct HgIn { u32x4 f0, f1, q0, q1, v; };
template <bool WITHQ> __device__ __forceinline__ void hg_load(HgIn& r, const bf16* H, int item, int dir, int dq, int wave, int lane) {
    const int seq = item >> 9, chunk = (item >> 3) & 63, head = item & 7;
    const size_t rowbase = (size_t)seq * SEQ + chunk * 64;
    const int tok = dir ? 63 - lane : lane;
    const bf16* hr = H + (rowbase + tok) * HP + head * 64 + 16 * dq;
    r.f0 = *(const u32x4*)(hr + C_HFF + dir * 512); r.f1 = *(const u32x4*)(hr + C_HFF + dir * 512 + 8);
    if (WITHQ) { r.q0 = *(const u32x4*)(hr + C_HQ); r.q1 = *(const u32x4*)(hr + C_HQ + 8); }
    r.v = *(const u32x4*)(H + (rowbase + lane) * HP + C_HI + head * 64 + 8 * wave);
}
__device__ __forceinline__ float bfel(const u32x4& a, const u32x4& b, int i) {
    const unsigned w = (i < 8) ? a[(i >> 1) & 3] : b[(i >> 1) & 3];
    return (i & 1) ? bfhi(w) : bflo(w);
}
__device__ __forceinline__ float dpp_shr(float v, int  ) { return v; }
__device__ __forceinline__ float wave_scan(float v, int lane) {
    v += __int_as_float(__builtin_amdgcn_update_dpp(0, __float_as_int(v), 0x111, 0xF, 0xF, false));
    v += __int_as_float(__builtin_amdgcn_update_dpp(0, __float_as_int(v), 0x112, 0xF, 0xF, false));
    v += __int_as_float(__builtin_amdgcn_update_dpp(0, __float_as_int(v), 0x114, 0xF, 0xF, false));
    v += __int_as_float(__builtin_amdgcn_update_dpp(0, __float_as_int(v), 0x118, 0xF, 0xF, false));
    v += __int_as_float(__builtin_amdgcn_update_dpp(0, __float_as_int(v), 0x142, 0xA, 0xF, false));
    v += __int_as_float(__builtin_amdgcn_update_dpp(0, __float_as_int(v), 0x143, 0xC, 0xF, false));
    return v;
}
__device__ __forceinline__ float lane_bcast(float v, int l) { return __int_as_float(__builtin_amdgcn_readlane(__float_as_int(v), l)); }
__device__ __forceinline__ unsigned short bf1(float x) { return (unsigned short)(pg8::cvt_pk_bf16(x, x) & 0xffffu); }

constexpr int HL_IN1 = 32768;
struct HgLines1 { u32x4 p[3]; };
__device__ __forceinline__ void hg_lines1_load(HgLines1& r, const bf16* H, int item, int tid) {
    const int seq = item >> 9, chunk = (item >> 3) & 63, head = item & 7, row = tid >> 3, piece = tid & 7;
    const bf16* hr = H + ((size_t)seq * SEQ + chunk * 64 + row) * HP + head * 64 + piece * 8;
    r.p[0] = *(const u32x4*)(hr + C_HFF); r.p[1] = *(const u32x4*)(hr + C_HFF + 512); r.p[2] = *(const u32x4*)(hr + C_HI);
}
__device__ __forceinline__ void hg_lines1_store(const HgLines1& r, LAS unsigned char* in, int tid) {
    LAS unsigned char* d = in + (tid >> 3) * 144 + (tid & 7) * 16;
#pragma unroll
    for (int a = 0; a < 3; ++a) *(LAS u32x4*)(d + a * 9216) = r.p[a];
}
__device__ __forceinline__ void hgrn_pass1(LAS unsigned char* lds, const bf16* H, bf16* SB, float* DEC, const float* lbp, int layer, int G, int cu) {
    int tid = threadIdx.x; asm volatile("" : "+v"(tid)); const int lane = tid & 63, wave = __builtin_amdgcn_readfirstlane(tid >> 6);
    const int fr = lane & 15, fq = lane >> 4, dir = wave >> 2, dq = wave & 3;
    const int tok = dir ? 63 - lane : lane;
    LAS unsigned short* KT = (LAS unsigned short*)(lds + HL_T0 + dir * HL_TSZ);
    LAS unsigned short* VT = (LAS unsigned short*)(lds + HL_T0 + 2 * HL_TSZ);
    LAS unsigned char* IN = lds + HL_IN1;
    HgIn cur; HgLines1 nl;
    if (cu < HG_ITEMS) { hg_lines1_load(nl, H, cu, tid); hg_lines1_store(nl, IN, tid); }
    __syncthreads();
    for (int item = cu; item < HG_ITEMS; item += G) {
        const int seq = item >> 9, chunk = (item >> 3) & 63, head = item & 7;
        const int gcol = dir * 512 + head * 64 + 16 * dq;
        {
            const LAS unsigned char* rf = IN + dir * 9216 + tok * 144 + dq * 32;
            cur.f0 = *(const LAS u32x4*)rf; cur.f1 = *(const LAS u32x4*)(rf + 16);
            cur.v = *(const LAS u32x4*)(IN + 2 * 9216 + lane * 144 + wave * 16);
        }
        float b[16], kk[16];
        f32x4 lbq[4];
#pragma unroll
        for (int i = 0; i < 4; ++i) lbq[i] = *(const f32x4*)(lbp + layer * 1024 + gcol + 4 * i);
#pragma unroll
        for (int i = 0; i < 16; ++i) {
            const float lb = lbq[i >> 2][i & 3];
            const float f = lb + (1.f - lb) * sigm(bfel(cur.f0, cur.f1, i));
            kk[i] = 1.f - f; b[i] = wave_scan(__builtin_amdgcn_logf(f), lane);
        }
        const u32x4 vv = cur.v;
        const int chain = (seq * 8 + head) * 2 + dir, cidx = dir ? 63 - chunk : chunk;
        float dcy[16];
#pragma unroll
        for (int i = 0; i < 16; ++i) {
            const float blast = lane_bcast(b[i], 63);
            KT[(16 * dq + i) * HG_P + tok] = bf1(kk[i] * __builtin_amdgcn_exp2f(blast - b[i]));
            dcy[i] = blast;
        }
        if (lane == 63) {
            float* dp = DEC + (size_t)(chain * 64 + cidx) * 64 + 16 * dq;
#pragma unroll
            for (int i = 0; i < 4; ++i) *(f32x4*)(dp + 4 * i) = (f32x4){dcy[4 * i], dcy[4 * i + 1], dcy[4 * i + 2], dcy[4 * i + 3]};
        }
        {
            LAS unsigned short* vp = VT + (8 * wave) * HG_P + lane;
            vp[0 * HG_P] = (unsigned short)(vv.x & 0xffffu); vp[1 * HG_P] = (unsigned short)(vv.x >> 16);
            vp[2 * HG_P] = (unsigned short)(vv.y & 0xffffu); vp[3 * HG_P] = (unsigned short)(vv.y >> 16);
            vp[4 * HG_P] = (unsigned short)(vv.z & 0xffffu); vp[5 * HG_P] = (unsigned short)(vv.z >> 16);
            vp[6 * HG_P] = (unsigned short)(vv.w & 0xffffu); vp[7 * HG_P] = (unsigned short)(vv.w >> 16);
        }
        __syncthreads();
        hg_lines1_load(nl, H, item + G < HG_ITEMS ? item + G : item, tid);
        f32x4 acc[4];
#pragma unroll
        for (int et = 0; et < 4; ++et) acc[et] = (f32x4){0.f, 0.f, 0.f, 0.f};
#pragma unroll
        for (int k2 = 0; k2 < 2; ++k2) {
            const bf16x8 a = *(const LAS bf16x8*)(KT + (16 * dq + fr) * HG_P + k2 * 32 + fq * 8);
#pragma unroll
            for (int et = 0; et < 4; ++et) {
                const bf16x8 bb = *(const LAS bf16x8*)(VT + (16 * et + fr) * HG_P + k2 * 32 + fq * 8);
                acc[et] = __builtin_amdgcn_mfma_f32_16x16x32_bf16(a, bb, acc[et], 0, 0, 0);
            }
        }
        bf16* sb = SB + (size_t)(chain * 64 + cidx) * 4096;
#pragma unroll
        for (int et = 0; et < 4; ++et) { u32x2 w; w.x = pg8::cvt_pk_bf16(acc[et][0], acc[et][1]); w.y = pg8::cvt_pk_bf16(acc[et][2], acc[et][3]); *(u32x2*)(sb + (16 * et + fr) * 64 + 16 * dq + 4 * fq) = w; }
        hg_lines1_store(nl, IN, tid);
        __syncthreads();
    }
    __syncthreads();
}
__device__ __forceinline__ void hgrn_prefix(bf16* SB, const float* DEC, int G, int cu) {
    int tid = threadIdx.x; asm volatile("" : "+v"(tid)); const int gid = cu * NTHR + tid, nthr = G * NTHR;
    for (int w = gid; w < GSEQ * 8 * 2 * 512; w += nthr) {
        const int chain = w >> 9, v = w & 511, d0 = (v & 7) * 8;
        u32x4* p = (u32x4*)(SB + (size_t)chain * 64 * 4096) + v;
        const f32x4* dp = (const f32x4*)(DEC + (size_t)chain * 64 * 64 + d0);
        f32x4 c0 = (f32x4){0.f, 0.f, 0.f, 0.f}, c1 = (f32x4){0.f, 0.f, 0.f, 0.f};
#pragma unroll 16
        for (int c = 0; c < 64; ++c) {
            const u32x4 t = p[(size_t)c * 512]; const f32x4 l0 = dp[c * 16], l1 = dp[c * 16 + 1];
            p[(size_t)c * 512] = pack8(c0, c1);
            const f32x4 t0 = (f32x4){bflo(t.x), bfhi(t.x), bflo(t.y), bfhi(t.y)}, t1 = (f32x4){bflo(t.z), bfhi(t.z), bflo(t.w), bfhi(t.w)};
            const f32x4 e0 = (f32x4){__builtin_amdgcn_exp2f(l0[0]), __builtin_amdgcn_exp2f(l0[1]), __builtin_amdgcn_exp2f(l0[2]), __builtin_amdgcn_exp2f(l0[3])}, e1 = (f32x4){__builtin_amdgcn_exp2f(l1[0]), __builtin_amdgcn_exp2f(l1[1]), __builtin_amdgcn_exp2f(l1[2]), __builtin_amdgcn_exp2f(l1[3])};
            c0 = e0 * c0 + t0; c1 = e1 * c1 + t1;
        }
    }
}
constexpr int HL_OB = HL_T0 + 7 * HL_TSZ;
constexpr int HL_IN = HL_OB + 64 * 68 * 4;
static_assert(HL_IN + 5 * HL_TSZ <= 131072, "HGRN LDS map");
struct HgLines { u32x4 p[5]; };
__device__ __forceinline__ void hg_lines_load(HgLines& r, const bf16* H, int item, int tid) {
    const int seq = item >> 9, chunk = (item >> 3) & 63, head = item & 7, row = tid >> 3, piece = tid & 7;
    const bf16* hr = H + ((size_t)seq * SEQ + chunk * 64 + row) * HP + head * 64 + piece * 8;
    r.p[0] = *(const u32x4*)(hr + C_HFF); r.p[1] = *(const u32x4*)(hr + C_HFF + 512); r.p[2] = *(const u32x4*)(hr + C_HQ); r.p[3] = *(const u32x4*)(hr + C_HI); r.p[4] = *(const u32x4*)(hr + C_HG);
}
__device__ __forceinline__ void hg_lines_store(const HgLines& r, LAS unsigned char* in, int tid) {
    LAS unsigned char* d = in + (tid >> 3) * 144 + (tid & 7) * 16;
#pragma unroll
    for (int a = 0; a < 5; ++a) *(LAS u32x4*)(d + a * HL_TSZ) = r.p[a];
}
__device__ __forceinline__ void hgrn_pass3(LAS unsigned char* lds, const bf16* H, const bf16* SB, bf16* OHG, const float* lbp, const float* ng, int layer, int G, int cu) {
    int tid = threadIdx.x; asm volatile("" : "+v"(tid)); const int lane = tid & 63, wave = __builtin_amdgcn_readfirstlane(tid >> 6);
    const int fr = lane & 15, fq = lane >> 4, dir = wave >> 2, dq = wave & 3;
    const int tok = dir ? 63 - lane : lane;
    LAS unsigned short* QT = (LAS unsigned short*)(lds + HL_T0 + (dir * 3 + 0) * HL_TSZ);
    LAS unsigned short* QS = (LAS unsigned short*)(lds + HL_T0 + (dir * 3 + 1) * HL_TSZ);
    LAS unsigned short* KT = (LAS unsigned short*)(lds + HL_T0 + (dir * 3 + 2) * HL_TSZ);
    LAS unsigned short* VT = (LAS unsigned short*)(lds + HL_T0 + 6 * HL_TSZ);
    LAS float* OB = (LAS float*)(lds + HL_OB);
    const int j = dq, tl = 16 * j + fr;
    f32x4 ngv[4];
#pragma unroll
    for (int et = 0; et < 4; ++et) ngv[et] = *(const f32x4*)(ng + 16 * et + 4 * fq);
    LAS unsigned char* IN = lds + HL_IN;
    HgIn cur; HgLines nl;
    if (cu < HG_ITEMS) { hg_lines_load(nl, H, cu, tid); hg_lines_store(nl, IN, tid); }
    __syncthreads();
    for (int item = cu; item < HG_ITEMS; item += G) {
        const int seq = item >> 9, chunk = (item >> 3) & 63, head = item & 7;
        const size_t rowbase = (size_t)seq * SEQ + chunk * 64;
        const int gcol = dir * 512 + head * 64 + 16 * dq;
        const int chain = (seq * 8 + head) * 2 + dir, cidx = dir ? 63 - chunk : chunk;
        const bf16* sb = SB + (size_t)(chain * 64 + cidx) * 4096;
        bf16x8 st[2][4];
#pragma unroll
        for (int k2 = 0; k2 < 2; ++k2)
#pragma unroll
            for (int et = 0; et < 4; ++et) st[k2][et] = *(const bf16x8*)(sb + (16 * et + fr) * 64 + k2 * 32 + fq * 8);
        {
            const LAS unsigned char* rf = IN + dir * HL_TSZ + tok * 144 + dq * 32;
            const LAS unsigned char* rq = IN + 2 * HL_TSZ + tok * 144 + dq * 32;
            cur.f0 = *(const LAS u32x4*)rf; cur.f1 = *(const LAS u32x4*)(rf + 16);
            cur.q0 = *(const LAS u32x4*)rq; cur.q1 = *(const LAS u32x4*)(rq + 16);
            cur.v = *(const LAS u32x4*)(IN + 3 * HL_TSZ + lane * 144 + wave * 16);
        }
        u32x2 hgw[4];
#pragma unroll
        for (int et = 0; et < 4; ++et) hgw[et] = *(const LAS u32x2*)(IN + 4 * HL_TSZ + tl * 144 + (16 * et + 4 * fq) * 2);
        float b[16], kk[16], qq[16];
        f32x4 lbq[4];
#pragma unroll
        for (int i = 0; i < 4; ++i) lbq[i] = *(const f32x4*)(lbp + layer * 1024 + gcol + 4 * i);
#pragma unroll
        for (int i = 0; i < 16; ++i) {
            const float lb = lbq[i >> 2][i & 3];
            const float f = lb + (1.f - lb) * sigm(bfel(cur.f0, cur.f1, i));
            kk[i] = 1.f - f; qq[i] = bfel(cur.q0, cur.q1, i); b[i] = wave_scan(__builtin_amdgcn_logf(f), lane);
        }
        const u32x4 vv = cur.v;
        float qt[16], qs[16], kt[16];
#pragma unroll
        for (int i = 0; i < 16; ++i) {
            const float bref = lane_bcast(b[i], 31);
            const float dcl = __builtin_amdgcn_fmed3f(b[i] - bref, -115.f, 115.f);
            qt[i] = qq[i] * __builtin_amdgcn_exp2f(dcl);
            qs[i] = qq[i] * __builtin_amdgcn_exp2f(b[i]);
            kt[i] = kk[i] * __builtin_amdgcn_exp2f(-dcl);
        }
        {
            const int o = tok * HG_P + 16 * dq;
            *(LAS u32x4*)(QT + o) = pack8((f32x4){qt[0], qt[1], qt[2], qt[3]}, (f32x4){qt[4], qt[5], qt[6], qt[7]});
            *(LAS u32x4*)(QT + o + 8) = pack8((f32x4){qt[8], qt[9], qt[10], qt[11]}, (f32x4){qt[12], qt[13], qt[14], qt[15]});
            *(LAS u32x4*)(QS + o) = pack8((f32x4){qs[0], qs[1], qs[2], qs[3]}, (f32x4){qs[4], qs[5], qs[6], qs[7]});
            *(LAS u32x4*)(QS + o + 8) = pack8((f32x4){qs[8], qs[9], qs[10], qs[11]}, (f32x4){qs[12], qs[13], qs[14], qs[15]});
            *(LAS u32x4*)(KT + o) = pack8((f32x4){kt[0], kt[1], kt[2], kt[3]}, (f32x4){kt[4], kt[5], kt[6], kt[7]});
            *(LAS u32x4*)(KT + o + 8) = pack8((f32x4){kt[8], kt[9], kt[10], kt[11]}, (f32x4){kt[12], kt[13], kt[14], kt[15]});
            LAS unsigned short* vp = VT + (8 * wave) * HG_P + lane;
            vp[0 * HG_P] = (unsigned short)(vv.x & 0xffffu); vp[1 * HG_P] = (unsigned short)(vv.x >> 16);
            vp[2 * HG_P] = (unsigned short)(vv.y & 0xffffu); vp[3 * HG_P] = (unsigned short)(vv.y >> 16);
            vp[4 * HG_P] = (unsigned short)(vv.z & 0xffffu); vp[5 * HG_P] = (unsigned short)(vv.z >> 16);
            vp[6 * HG_P] = (unsigned short)(vv.w & 0xffffu); vp[7 * HG_P] = (unsigned short)(vv.w >> 16);
        }
        __syncthreads();
        hg_lines_load(nl, H, item + G < HG_ITEMS ? item + G : item, tid);
        bf16x8 qf[2];
        qf[0] = *(const LAS bf16x8*)(QT + tl * HG_P + fq * 8); qf[1] = *(const LAS bf16x8*)(QT + tl * HG_P + 32 + fq * 8);
        f32x4 as[4];
#pragma unroll
        for (int s4 = 0; s4 < 4; ++s4) {
            as[s4] = (f32x4){0.f, 0.f, 0.f, 0.f};
#pragma unroll
            for (int k2 = 0; k2 < 2; ++k2) {
                const bf16x8 a = *(const LAS bf16x8*)(KT + (16 * s4 + fr) * HG_P + k2 * 32 + fq * 8);
                as[s4] = __builtin_amdgcn_mfma_f32_16x16x32_bf16(a, qf[k2], as[s4], 0, 0, 0);
            }
#pragma unroll
            for (int i = 0; i < 4; ++i) { const int sidx = 16 * s4 + 4 * fq + i; const bool keep = dir ? (sidx >= tl) : (sidx <= tl); as[s4][i] = keep ? as[s4][i] : 0.f; }
        }
        f32x4 o[4];
#pragma unroll
        for (int et = 0; et < 4; ++et) o[et] = (f32x4){0.f, 0.f, 0.f, 0.f};
#pragma unroll
        for (int kb = 0; kb < 2; ++kb) {
            const bf16x8 pb = __builtin_bit_cast(bf16x8, pack8(as[2 * kb], as[2 * kb + 1]));
#pragma unroll
            for (int et = 0; et < 4; ++et) {
                const LAS unsigned short* vp = VT + (16 * et + fr) * HG_P + kb * 32 + 4 * fq;
                const u32x2 lo = *(const LAS u32x2*)vp, hi = *(const LAS u32x2*)(vp + 16);
                const bf16x8 a = __builtin_bit_cast(bf16x8, (u32x4){lo.x, lo.y, hi.x, hi.y});
                o[et] = __builtin_amdgcn_mfma_f32_16x16x32_bf16(a, pb, o[et], 0, 0, 0);
            }
        }
#pragma unroll
        for (int k2 = 0; k2 < 2; ++k2) {
            const bf16x8 bq = *(const LAS bf16x8*)(QS + tl * HG_P + k2 * 32 + fq * 8);
#pragma unroll
            for (int et = 0; et < 4; ++et) {
                o[et] = __builtin_amdgcn_mfma_f32_16x16x32_bf16(st[k2][et], bq, o[et], 0, 0, 0);
            }
        }
        if (dir == 1) {
#pragma unroll
            for (int et = 0; et < 4; ++et) *(LAS f32x4*)(OB + tl * 68 + 16 * et + 4 * fq) = o[et];
        }
        hg_lines_store(nl, IN, tid);
        __syncthreads();
        if (dir == 0) {
            float ss = 0.f;
#pragma unroll
            for (int et = 0; et < 4; ++et) { o[et] = o[et] + *(const LAS f32x4*)(OB + tl * 68 + 16 * et + 4 * fq); ss += (o[et][0] * o[et][0] + o[et][1] * o[et][1]) + (o[et][2] * o[et][2] + o[et][3] * o[et][3]); }
            ss += __shfl_xor(ss, 16); ss += __shfl_xor(ss, 32);
            const float r = 1.f / sqrtf(ss * (1.f / 64.f) + RMS_EPS);
            const size_t row = rowbase + tl;
#pragma unroll
            for (int et = 0; et < 4; ++et) {
                const int e0 = 16 * et + 4 * fq;
                const f32x4 g4 = ngv[et];
                const float h0 = bflo(hgw[et].x), h1 = bfhi(hgw[et].x), h2 = bflo(hgw[et].y), h3 = bfhi(hgw[et].y);
                const float y0 = o[et][0] * r * g4[0] * h0, y1 = o[et][1] * r * g4[1] * h1;
                const float y2 = o[et][2] * r * g4[2] * h2, y3 = o[et][3] * r * g4[3] * h3;
                u32x2 w; w.x = pg8::cvt_pk_bf16(y0, y1); w.y = pg8::cvt_pk_bf16(y2, y3);
                *(u32x2*)(OHG + row * 512 + head * 64 + e0) = w;
            }
        }
    }
    __syncthreads();
}

#define XB_TMO      128
#define XB_XCNT(j)  (256  + 64 * (j))
#define XB_XSUB(j)  (1280 + 64 * (j))
#define XB_XGEN(j)  (2304 + 64 * (j))
#define XB_TOP      3328
#define XB_TOPGEN   3392
#define XCD_BAR_WORDS 3456
#define XB_SPIN_CAP (1u << 18)

__device__ __forceinline__ unsigned xb_ld(unsigned* p)              { return __hip_atomic_load(p, __ATOMIC_RELAXED, __HIP_MEMORY_SCOPE_AGENT); }
__device__ __forceinline__ unsigned xb_add(unsigned* p, unsigned v) { return __hip_atomic_fetch_add(p, v, __ATOMIC_RELAXED, __HIP_MEMORY_SCOPE_AGENT); }
__device__ __forceinline__ unsigned xb_xcc_id() { return (unsigned)__builtin_amdgcn_s_getreg((3 << 11) | 20) & 0xFu; }
#define XB_SPIN(cond, bar) do { unsigned _sp = 0; while (cond) { __builtin_amdgcn_s_sleep(1); \
    if ((++_sp & 255u) == 0u) { if (xb_ld(&(bar)[XB_TMO])) break; if (_sp > XB_SPIN_CAP) { atomicAdd(&(bar)[XB_TMO], 1u); break; } } } } while (0)

struct XcdBarrier {
    unsigned* bar; unsigned x;
    volatile LAS unsigned* st;
};

__device__ __forceinline__ XcdBarrier xcd_barrier_post(unsigned* bar, volatile LAS unsigned* st) {
    XcdBarrier b; b.bar = bar; b.x = xb_xcc_id(); b.st = st;
    if (threadIdx.x == 0) (void)xb_add(&bar[XB_XCNT(b.x)], 1u);
    return b;
}
__device__ __forceinline__ void xcd_barrier_complete(unsigned* bar, unsigned x, unsigned& nloc, unsigned& nx) {
    const unsigned G = gridDim.x * gridDim.y * gridDim.z;
    unsigned sum, cnt, mine, sp = 0u;
    for (;;) {
        sum = 0u; cnt = 0u; mine = 0u;
#pragma unroll
        for (unsigned j = 0; j < 16; ++j) { const unsigned c = xb_ld(&bar[XB_XCNT(j)]); sum += c; cnt += (c > 0u) ? 1u : 0u; mine = (j == x) ? c : mine; }
        if (sum == G) break;
        __builtin_amdgcn_s_sleep(1);
        if ((++sp & 255u) == 0u) { if (xb_ld(&bar[XB_TMO])) break; if (sp > XB_SPIN_CAP) { atomicAdd(&bar[XB_TMO], 1u); break; } }
    }
    nloc = mine > 0u ? mine : 1u; nx = cnt > 0u ? cnt : 1u;
}

__device__ __forceinline__ void xcd_barrier(const XcdBarrier& b) {
    asm volatile("s_waitcnt vmcnt(0)" ::: "memory");
    __syncthreads();
    if (threadIdx.x == 0) {
        unsigned* bar = b.bar; asm volatile("" : "+s"(bar));
        __builtin_amdgcn_s_waitcnt(0);
        unsigned nloc = b.st[0], nx = b.st[1];
        if (nloc == 0u) { xcd_barrier_complete(bar, b.x, nloc, nx); b.st[0] = nloc; b.st[1] = nx; }
        const unsigned old = xb_add(&bar[XB_XSUB(b.x)], 1u);
        const unsigned gen = old / nloc;
        if (old + 1u == (gen + 1u) * nloc) {
            __builtin_amdgcn_fence(__ATOMIC_RELEASE, "agent");
            asm volatile("s_waitcnt vmcnt(0)" ::: "memory");
            const unsigned og = xb_add(&bar[XB_TOP], 1u);
            const unsigned tg = og / nx;
            if (og + 1u == (tg + 1u) * nx) xb_add(&bar[XB_TOPGEN], 1u);
            else XB_SPIN(xb_ld(&bar[XB_TOPGEN]) == tg, bar);
            __builtin_amdgcn_fence(__ATOMIC_ACQUIRE, "agent");
            xb_add(&bar[XB_XGEN(b.x)], 1u);
            asm volatile("s_waitcnt vmcnt(0)" ::: "memory");
        } else {
            XB_SPIN(xb_ld(&bar[XB_XGEN(b.x)]) == gen, bar);
            __builtin_amdgcn_fence(__ATOMIC_ACQUIRE, "agent");
            asm volatile("s_waitcnt vmcnt(0)" ::: "memory");
        }
    }
    __syncthreads();
}

struct Args { const float* xin[2]; const float *w_in, *sink, *lb, *ng, *wpa, *wph, *wout, *ln1g, *ln1b, *ff1, *ff2, *ln2g, *ln2b; float* out; unsigned char* ws; };

__global__ void __launch_bounds__(NTHR, 2) fwd_kernel(Args a) {
    extern __shared__ __attribute__((aligned(16))) unsigned char lds_raw[];
    LAS unsigned char* lds = (LAS unsigned char*)lds_raw;
    cg::grid_group grid = cg::this_grid();
    const int G = gridDim.x, cu = blockIdx.x;
    volatile LAS unsigned* bst = (volatile LAS unsigned*)(lds + 131072 + 64);
    if (threadIdx.x < 2) bst[threadIdx.x] = 0u;
    __syncthreads();
    const XcdBarrier bar = xcd_barrier_post((unsigned*)a.ws, bst);
#define WSQ(T, off) ((T)({ unsigned char* p_ = a.ws; asm volatile("" : "+s"(p_)); p_ + (off); }))

    {
        int tid = threadIdx.x; asm volatile("" : "+v"(tid)); const int lane = tid & 63, wave = __builtin_amdgcn_readfirstlane(tid >> 6);
        const int gw = cu * 8 + wave, NGW = G * 8, gid = cu * NTHR + tid, nthr = G * NTHR;
        LAS float* scr = (LAS float*)(lds + wave * 16384);
        unsigned char* ws = a.ws;
        constexpr int I_IN = 16 * 168, I_PA = 8 * 32, I_OUT = 16 * 32, I_F1 = 16 * 128, I_F2 = 64 * 32;
        constexpr int I_L = I_IN + 2 * I_PA + I_OUT + I_F1 + I_F2;
        for (int it = gw; it < 2 * I_L; it += NGW) {
            const int l = it / I_L; int r = it - l * I_L;
            unsigned char* wl = ws + WS_W + (size_t)l * WS_WL;
            if (r < I_IN) { if (l == 0) transpose_item(a.w_in, DM, HP, (bf16*)wl, scr, r, lane, nullptr, nullptr, nullptr, nullptr);
                              else transpose_item(a.w_in + (size_t)DM * HP, DM, HP, (bf16*)wl, scr, r, lane, a.ln2g, a.ln2b, (float*)(ws + WS_CSIN), (float*)(ws + WS_BWIN)); continue; } r -= I_IN;
            if (r < I_PA) { transpose_item(a.wpa + (size_t)l * 512 * DM, 512, DM, (bf16*)(wl + WO_PA), scr, r, lane, nullptr, nullptr, nullptr, nullptr); continue; } r -= I_PA;
            if (r < I_PA) { transpose_item(a.wph + (size_t)l * 512 * DM, 512, DM, (bf16*)(wl + WO_PH), scr, r, lane, nullptr, nullptr, nullptr, nullptr); continue; } r -= I_PA;
            if (r < I_OUT) { transpose_item(a.wout + (size_t)l * DM * DM, DM, DM, (bf16*)(wl + WO_OUT), scr, r, lane, nullptr, nullptr, nullptr, nullptr); continue; } r -= I_OUT;
            if (r < I_F1) { transpose_item(a.ff1 + (size_t)l * DM * DFF, DM, DFF, (bf16*)(wl + WO_FF1), scr, r, lane, a.ln1g + l * DM, a.ln1b + l * DM, (float*)(ws + WS_CS1) + l * DFF, (float*)(ws + WS_BW1) + l * DFF); continue; } r -= I_F1;
            transpose_item(a.ff2 + (size_t)l * DFF * DM, DFF, DM, (bf16*)(wl + WO_FF2), scr, r, lane, nullptr, nullptr, nullptr, nullptr);
        }
        for (int w = gid; w < 2048; w += nthr) ((float*)(ws + WS_LBV))[w] = w < 1024 ? 0.f : sigm(a.lb[w] - a.lb[w - 1024]);
        float* ROPE = (float*)(ws + WS_ROPE);
        for (int w = gid; w < SEQ * 8; w += nthr) {
            const int pos = w >> 3, i = w & 7;
            const float invf = i == 0 ? 1.0f : i == 1 ? 0.19392274474868576f : i == 2 ? 0.03760603093086393f : i == 3 ? 0.007292664737217109f
                             : i == 4 ? 0.001414213562373095f : i == 5 ? 0.0002742481756762073f : i == 6 ? 5.318295896944988e-05f : 1.031338537721246e-05f;
            const float ang = (float)pos * invf;
            const double rev = (double)ang * 0.15915494309189535;
            const float fr_ = (float)(rev - __builtin_rint(rev));
            ROPE[pos * 16 + i] = __builtin_amdgcn_cosf(fr_); ROPE[pos * 16 + 8 + i] = __builtin_amdgcn_sinf(fr_);
        }
    }
    grid.sync();

#define OG_PTR() ({ float* p_ = a.out; int gg_ = g; asm volatile("" : "+s"(p_), "+s"(gg_)); (float*)((unsigned long long)p_ + (unsigned long long)(unsigned)gg_ * ((unsigned long long)MG * DM * 4ull)); })
#define SEL_PTR(c, pa, pb) ({ unsigned long long a_ = (unsigned long long)(pa), b_ = (unsigned long long)(pb); int c_ = (c); asm volatile("" : "+s"(a_), "+s"(b_), "+s"(c_)); \
        const unsigned long long r_ = b_ + ((a_ - b_) & (0ull - (unsigned long long)(c_ != 0))); \
        (const float*)(((unsigned long long)(unsigned)__builtin_amdgcn_readfirstlane((unsigned)(r_ >> 32)) << 32) | (unsigned)__builtin_amdgcn_readfirstlane((unsigned)r_)); })
#define WL(off) WSQ(const bf16*, WS_W + (size_t)l * WS_WL + (off))
#pragma unroll 1
    for (int g = 0; g < NGROUPS; ++g) {
        {
            bf16* XB = WSQ(bf16*, WS_XB); const float* xp = a.xin[0]; const float* xv = a.xin[1] - (size_t)XSPLIT * DM;
            int tidc = threadIdx.x; asm volatile("" : "+v"(tidc)); const int gid = cu * NTHR + tidc, nthr = G * NTHR;
            for (int w = gid; w < MG * DM / 8; w += nthr) {
                const size_t e = (size_t)g * MG * DM + (size_t)w * 8; const float* src = (e < (size_t)XSPLIT * DM ? xp : xv) + e;
                const f32x4 v0 = *(const f32x4*)src, v1 = *(const f32x4*)(src + 4);
                *(u32x4*)(XB + (size_t)w * 8) = pack8(v0, v1);
            }
        }
        xcd_barrier(bar);
#pragma unroll 1
        for (int l = 0; l < 2; ++l) {
            { pg8::Gemm gm{WSQ(const bf16*, WS_XB), WL(0), MG, HP, DM}; pg8::StaticOrder S; S.init(MG, HP, G, cu);
              EpiH E{WSQ(bf16*, WS_H), WSQ(const float*, WS_ROPE), WSQ(const float*, WS_ST2), WSQ(const float*, WS_CSIN), WSQ(const float*, WS_BWIN), l};
              pg8::gemm_phase<EpiH, pg8::StaticOrder, true, true>(lds, gm, S, E); }
            xcd_barrier(bar);
            hgrn_pass1(lds, WSQ(const bf16*, WS_H), WSQ(bf16*, WS_SB), WSQ(float*, WS_DEC), WSQ(const float*, WS_LBV), l, G, cu);
            xcd_barrier(bar);
            { const int GP = G >= 8 ? G / 4 : 0, isp = (cu & 3) == 3;
              const int pG = GP ? GP : G, pcu = GP ? (isp ? (cu >> 2) : (1 << 20)) : cu;
              const int aG = GP ? G - GP : G, acu = GP ? (isp ? (1 << 20) : cu - (cu >> 2)) : cu;
              hgrn_prefix(WSQ(bf16*, WS_SB), WSQ(const float*, WS_DEC), pG, pcu);
              attn_phase(lds, WSQ(const bf16*, WS_H), WSQ(bf16*, WS_OATT), a.sink + l * 8, aG, acu); }
            { float* ST1 = WSQ(float*, WS_ST1); float* ST2 = WSQ(float*, WS_ST2);
              int tz = threadIdx.x; asm volatile("" : "+v"(tz)); for (int w = cu * NTHR + tz; w < 2 * MG; w += G * NTHR) { ST1[w] = 0.f; if (l == 0) { ST2[w] = 0.f; ST2[2 * MG + w] = 0.f; } } }
            xcd_barrier(bar);
            { pg8::Gemm gm{WSQ(const bf16*, WS_OATT), WL(WO_PA), MG, DM, 512}; pg8::StaticOrder S; S.init(MG, DM, G, cu);
              EpiMix<false> E{WSQ(const bf16*, WS_H) + C_GA, WSQ(bf16*, WS_MIX)};
              pg8::gemm_phase<EpiMix<false>, pg8::StaticOrder, true, true>(lds, gm, S, E); }
            hgrn_pass3(lds, WSQ(const bf16*, WS_H), WSQ(const bf16*, WS_SB), WSQ(bf16*, WS_OHG), WSQ(const float*, WS_LBV), a.ng + l * 64, l, G, cu);
            xcd_barrier(bar);
            { pg8::Gemm gm{WSQ(const bf16*, WS_OHG), WL(WO_PH), MG, DM, 512}; pg8::StaticOrder S; S.init(MG, DM, G, cu);
              EpiMix<true> E{WSQ(const bf16*, WS_H) + C_GB, WSQ(bf16*, WS_MIX)};
              pg8::gemm_phase<EpiMix<true>, pg8::StaticOrder, true, true>(lds, gm, S, E); }
            xcd_barrier(bar);
            { pg8::Gemm gm{WSQ(const bf16*, WS_MIX), WL(WO_OUT), MG, DM, DM}; pg8::StaticOrder S; S.init(MG, DM, G, cu);
              EpiRes E{WSQ(bf16*, WS_XB), l, WSQ(const float*, WS_ST2), a.ln2g, a.ln2b, WSQ(float*, WS_ST1)};
              pg8::gemm_phase<EpiRes, pg8::StaticOrder, true, true>(lds, gm, S, E); }
            xcd_barrier(bar);
            { pg8::Gemm gm{WSQ(const bf16*, WS_XB), WL(WO_FF1), MG, DFF, DM}; pg8::StaticOrder S; S.init(MG, DFF, G, cu);
              EpiFF1 E{WSQ(bf16*, WS_H), WSQ(const float*, WS_ST1), WSQ(const float*, WS_CS1) + l * DFF, WSQ(const float*, WS_BW1) + l * DFF};
              pg8::gemm_phase<EpiFF1, pg8::StaticOrder, true, true>(lds, gm, S, E); }
            xcd_barrier(bar);
            { pg8::Gemm gm{WSQ(const bf16*, WS_H), WL(WO_FF2), MG, DM, DFF}; pg8::StaticOrder S; S.init(MG, DM, G, cu);
              EpiRes E{WSQ(bf16*, WS_XB), 1, WSQ(const float*, WS_ST1), a.ln1g + l * DM, a.ln1b + l * DM, WSQ(float*, WS_ST2) + (size_t)l * 2 * MG};
              pg8::gemm_phase<EpiRes, pg8::StaticOrder, true, true>(lds, gm, S, E); }
            xcd_barrier(bar);
            if (l == 1) { ln_final(WSQ(const bf16*, WS_XB), WSQ(const float*, WS_ST2) + (size_t)2 * MG, OG_PTR(), a.ln2g + DM, a.ln2b + DM, G, cu); xcd_barrier(bar); }
        }
    }
}

extern "C" void kernel_launch(void* const* d_in, const int* in_sizes, int n_in, void* d_out, int out_size, void* d_ws, size_t ws_size, hipStream_t stream) {
    static int grid = 0;
    if (grid == 0) {
        if (n_in != 15 || ws_size < WS_END) { fprintf(stderr, "kernel_launch: unexpected n_in %d / ws_size %zu\n", n_in, ws_size); grid = -1; return; }
        int dev = 0, cus = 0, per_cu = 0;
        (void)hipGetDevice(&dev);
        (void)hipDeviceGetAttribute(&cus, hipDeviceAttributeMultiprocessorCount, dev);
        if (hipFuncSetAttribute((const void*)fwd_kernel, hipFuncAttributeMaxDynamicSharedMemorySize, LDS_BYTES) != hipSuccess) { fprintf(stderr, "kernel_launch: hipFuncSetAttribute failed\n"); grid = -1; return; }
        if (hipOccupancyMaxActiveBlocksPerMultiprocessor(&per_cu, (const void*)fwd_kernel, NTHR, LDS_BYTES) != hipSuccess || per_cu < 1) per_cu = 1;
        (void)hipGetLastError();
        grid = cus * per_cu;
    }
    if (grid < 0) return;
    Args a{};
    a.xin[0] = (const float*)d_in[0]; a.xin[1] = (const float*)d_in[1];
    a.w_in = (const float*)d_in[2]; a.sink = (const float*)d_in[3]; a.lb = (const float*)d_in[4]; a.ng = (const float*)d_in[5];
    a.wpa = (const float*)d_in[6]; a.wph = (const float*)d_in[7]; a.wout = (const float*)d_in[8];
    a.ln1g = (const float*)d_in[9]; a.ln1b = (const float*)d_in[10]; a.ff1 = (const float*)d_in[11]; a.ff2 = (const float*)d_in[12];
    a.ln2g = (const float*)d_in[13]; a.ln2b = (const float*)d_in[14];
    a.out = (float*)d_out; a.ws = (unsigned char*)d_ws;
    if (hipMemsetAsync(d_ws, 0, 1 << 20, stream) != hipSuccess) { fprintf(stderr, "kernel_launch: memset failed\n"); return; }
    void* args[] = {&a};
    hipError_t e = hipLaunchCooperativeKernel((const void*)fwd_kernel, dim3(grid), dim3(NTHR), args, LDS_BYTES, stream);
    if (e != hipSuccess) fprintf(stderr, "cooperative launch failed: %s (grid %d)\n", hipGetErrorString(e), grid);
}
```
